# Optimizing an MI355X kernel written in HIP

```python
import math
import jax
import jax.numpy as jnp
from jax import lax
import numpy as np

D_MODEL = 1024
BATCH = 32
SEQ = 2048
DEPTH = 1
DEC_BATCH = 8
DEC_SEQ = 16
PAST_LEN = 2048

CHUNK = 64
N_HEADS_A = 8
DK_A = 128
DV_A = 128
CONV_W = 4
N_HEADS_B = 8
DK_B = 128
DV_B = 128
HGRN_BLOCK = 16
D_FF = -(-8 * D_MODEL // (3 * 256)) * 256
WA_QK = N_HEADS_A * DK_A
WA_V = N_HEADS_A * DV_A
WB_K = N_HEADS_B * DK_B
WB_V = N_HEADS_B * DV_B
CONV_CH = 2 * WA_QK + WA_V
IN_SIZES = (WA_QK, WA_QK, WA_V, WA_V, N_HEADS_A, N_HEADS_A, WB_K, WB_K, WB_V, WB_V, D_MODEL, D_MODEL)
IN_TOTAL = sum(IN_SIZES)
ALPHA = (2.0 * DEPTH) ** 0.25
BETA_INIT = (8.0 * DEPTH) ** -0.25
LN_EPS = 1e-5
RMS_EPS = 1e-6
L2_EPS = 1e-6

kernel_name = 'hybrid_gdn_hgrn2_streaming_step'


def _split_points():
    return [int(s) for s in np.cumsum(IN_SIZES)[:-1]]


def _layer_norm(x, g, b):
    xf = x.astype(jnp.float32)
    mu = jnp.mean(xf, -1, keepdims=True)
    var = jnp.mean(jnp.square(xf - mu), -1, keepdims=True)
    y = (xf - mu) * lax.rsqrt(var + LN_EPS) * g.astype(jnp.float32) + b.astype(jnp.float32)
    return y.astype(x.dtype)


def _rms_heads(o, w):
    return o * lax.rsqrt(jnp.mean(o * o, -1, keepdims=True) + RMS_EPS) * w.astype(jnp.float32)


def _l2norm(x):
    return x * lax.rsqrt(jnp.sum(x * x, -1, keepdims=True) + L2_EPS)


def _causal_conv(u, buf, w):
    L = u.shape[1]
    up = jnp.concatenate([buf, u], axis=1)
    y = up[:, 0:L] * w[0]
    for j in range(1, CONV_W):
        y = y + up[:, j:j + L] * w[j]
    return jax.nn.silu(y), up[:, -(CONV_W - 1):]


def _to_blocks(t, c):
    B, L = t.shape[:2]
    n = -(-L // c)
    t = jnp.pad(t, [(0, 0), (0, n * c - L)] + [(0, 0)] * (t.ndim - 2))
    t = t.reshape((B, n, c) + t.shape[2:])
    return jnp.swapaxes(jnp.moveaxis(t, 3, 2), 0, 1)


def _from_blocks(o, L):
    o = jnp.moveaxis(jnp.swapaxes(o, 0, 1), 2, 3)
    B, n, c = o.shape[:3]
    return o.reshape((B, n * c) + o.shape[3:])[:, :L]


def _gated_delta_chunked(q, k, v, g, beta, s0):
    L = q.shape[1]
    c = CHUNK
    qb, kb, vb = _to_blocks(q, c), _to_blocks(k, c), _to_blocks(v, c)
    gb, bb = _to_blocks(g, c), _to_blocks(beta, c)
    incl = jnp.tril(jnp.ones((c, c), dtype=bool))
    strict = jnp.tril(jnp.ones((c, c), dtype=bool), -1)
    gc = jnp.cumsum(gb, axis=-1)
    diff = gc[..., :, None] - gc[..., None, :]
    decay = jnp.where(incl, jnp.exp(jnp.where(incl, diff, 0.0)), 0.0)
    k_beta = kb * bb[..., None]
    v_beta = vb * bb[..., None]
    lmat = jnp.where(strict, jnp.einsum('nbhtk,nbhsk->nbhts', k_beta, kb) * decay, 0.0)
    rhs = jnp.concatenate([v_beta, k_beta * jnp.exp(gc)[..., None]], axis=-1)
    sol = lax.linalg.triangular_solve(lmat, rhs, left_side=True, lower=True, unit_diagonal=True)
    value, k_cum = sol[..., :DV_A], sol[..., DV_A:]
    a_qk = jnp.einsum('nbhtk,nbhsk->nbhts', qb, kb) * decay
    q_dec = qb * jnp.exp(gc)[..., None]
    k_dec = kb * jnp.exp(gc[..., -1:] - gc)[..., None]
    last_dec = jnp.exp(gc[..., -1])

    def step(s, xs):
        qi, ki, vi, kci, ai, ld = xs
        v_new = vi - jnp.einsum('bhtk,bhkv->bhtv', kci, s)
        o = jnp.einsum('bhtk,bhkv->bhtv', qi, s) + jnp.einsum('bhts,bhsv->bhtv', ai, v_new)
        s = s * ld[..., None, None] + jnp.einsum('bhtk,bhtv->bhkv', ki, v_new)
        return s, o

    s_final, o = lax.scan(step, s0, (q_dec, k_dec, value, k_cum, a_qk, last_dec))
    return _from_blocks(o, L), s_final


def _hgrn2_chunked(q, k, v, logf, s0):
    L = q.shape[1]
    c = HGRN_BLOCK
    qb, kb, vb, fb = _to_blocks(q, c), _to_blocks(k, c), _to_blocks(v, c), _to_blocks(logf, c)
    incl = jnp.tril(jnp.ones((c, c), dtype=bool))[:, :, None]

    def step(s, xs):
        qi, ki, vi, lfi = xs
        bcum = jnp.cumsum(lfi, axis=2)
        blast = bcum[:, :, -1]
        diff = bcum[:, :, :, None, :] - bcum[:, :, None, :, :]
        dec = jnp.where(incl, jnp.exp(jnp.where(incl, diff, 0.0)), 0.0)
        a = jnp.einsum('bhtk,bhsk,bhtsk->bhts', qi, ki, dec)
        o = jnp.einsum('bhtk,bhkv->bhtv', qi * jnp.exp(bcum), s) + jnp.einsum('bhts,bhsv->bhtv', a, vi)
        s = s * jnp.exp(blast)[..., None] + jnp.einsum('bhsk,bhsv->bhkv', ki * jnp.exp(blast[:, :, None, :] - bcum), vi)
        return s, o

    s_final, o = lax.scan(step, s0, (qb, kb, vb, fb))
    return _from_blocks(o, L), s_final


def _token_mixers(x, conv_buf, s_gdn, s_hgrn, w_in, conv_w, a_log, dt_bias, gdn_norm_w, lb,
                  hgrn_norm_w, w_br_a, w_br_b, w_out):
    f32 = jnp.float32
    B, L, _ = x.shape
    proj = (x @ w_in).astype(f32)
    qa, ka, va, ga, aa, ba, qh, fh, ih, gh, mga, mgb = jnp.split(proj, _split_points(), axis=-1)
    qkv, new_buf = _causal_conv(jnp.concatenate([qa, ka, va], axis=-1), conv_buf.astype(f32), conv_w.astype(f32))
    qa, ka, va = jnp.split(qkv, [WA_QK, 2 * WA_QK], axis=-1)
    qa = _l2norm(qa.reshape(B, L, N_HEADS_A, DK_A)) * DK_A ** -0.5
    ka = _l2norm(ka.reshape(B, L, N_HEADS_A, DK_A))
    va = va.reshape(B, L, N_HEADS_A, DV_A)
    g = -jnp.exp(a_log.astype(f32)) * jax.nn.softplus(aa + dt_bias.astype(f32))
    beta = jax.nn.sigmoid(ba)
    oa, s_gdn_new = _gated_delta_chunked(qa, ka, va, g, beta, s_gdn.astype(f32))
    oa = _rms_heads(oa, gdn_norm_w) * jax.nn.silu(ga.reshape(B, L, N_HEADS_A, DV_A))
    z = fh.reshape(B, L, N_HEADS_B, DK_B)
    lbf = lb.astype(f32)
    logf = jnp.log(lbf + (1.0 - lbf) * jax.nn.sigmoid(z))
    kh = (1.0 - lbf) * jax.nn.sigmoid(-z)
    qh = jax.nn.silu(qh.reshape(B, L, N_HEADS_B, DK_B)) * DK_B ** -0.5
    vh = ih.reshape(B, L, N_HEADS_B, DV_B)
    ob, s_hgrn_new = _hgrn2_chunked(qh, kh, vh, logf, s_hgrn.astype(f32))
    ob = _rms_heads(ob, hgrn_norm_w) * jax.nn.sigmoid(gh.reshape(B, L, N_HEADS_B, DV_B))
    ya = oa.reshape(B, L, WA_V).astype(x.dtype) @ w_br_a
    yb = ob.reshape(B, L, WB_V).astype(x.dtype) @ w_br_b
    merged = jax.nn.sigmoid(mga).astype(x.dtype) * ya + jax.nn.sigmoid(mgb).astype(x.dtype) * yb
    return (merged @ w_out, new_buf.astype(x.dtype), s_gdn_new.astype(x.dtype), s_hgrn_new.astype(x.dtype))


def _layer(x, conv_buf, s_gdn, s_hgrn, w_in, conv_w, a_log, dt_bias, gdn_norm_w, lb, hgrn_norm_w,
           w_br_a, w_br_b, w_out, ln1_g, ln1_b, w_gate_up, w_down, ln2_g, ln2_b):
    mix, new_buf, s_gdn_new, s_hgrn_new = _token_mixers(x, conv_buf, s_gdn, s_hgrn, w_in, conv_w, a_log, dt_bias,
                                                        gdn_norm_w, lb, hgrn_norm_w, w_br_a, w_br_b, w_out)
    x = _layer_norm(ALPHA * x + mix, ln1_g, ln1_b)
    gate, up = jnp.split(x @ w_gate_up, 2, axis=-1)
    x = _layer_norm(ALPHA * x + (jax.nn.silu(gate) * up) @ w_down, ln2_g, ln2_b)
    return x, new_buf, s_gdn_new, s_hgrn_new


def setup_inputs(seed: int = 0) -> dict:
    key = jax.random.key(seed)
    ks = jax.random.split(key, 24)

    def nrm(k, shape, s):
        return jax.random.normal(k, shape, jnp.float32) * s

    dt = jnp.exp(jax.random.uniform(ks[8], (DEPTH, N_HEADS_A), jnp.float32, math.log(1e-3), math.log(1e-1)))
    return {
        'x_prompt': nrm(ks[0], (BATCH, SEQ, D_MODEL), 1.0),
        'x_sample': nrm(ks[1], (DEC_BATCH, DEC_SEQ, D_MODEL), 1.0),
        'cache_gdn_conv': nrm(ks[2], (DEPTH, DEC_BATCH, CONV_W - 1, CONV_CH), 1.0),
        'state_gdn': nrm(ks[3], (DEPTH, DEC_BATCH, N_HEADS_A, DK_A, DV_A), 0.1),
        'state_hgrn': nrm(ks[4], (DEPTH, DEC_BATCH, N_HEADS_B, DK_B, DV_B), 0.1),
        'w_in': nrm(ks[5], (DEPTH, D_MODEL, IN_TOTAL), D_MODEL ** -0.5),
        'conv_w': nrm(ks[6], (DEPTH, CONV_W, CONV_CH), CONV_W ** -0.5),
        'a_log': jnp.log(jax.random.uniform(ks[7], (DEPTH, N_HEADS_A), jnp.float32, 1.0, 16.0)),
        'dt_bias': dt + jnp.log(-jnp.expm1(-dt)),
        'gdn_norm_w': 1.0 + nrm(ks[9], (DEPTH, DV_A), 0.02),
        'hgrn_lb_logits': nrm(ks[10], (DEPTH + 1, WB_K), 0.5),
        'hgrn_norm_w': 1.0 + nrm(ks[11], (DEPTH, DV_B), 0.02),
        'w_br_a': nrm(ks[12], (DEPTH, WA_V, D_MODEL), WA_V ** -0.5),
        'w_br_b': nrm(ks[13], (DEPTH, WB_V, D_MODEL), WB_V ** -0.5),
        'w_out': nrm(ks[14], (DEPTH, D_MODEL, D_MODEL), BETA_INIT * D_MODEL ** -0.5),
        'ln1_g': 1.0 + nrm(ks[15], (DEPTH, D_MODEL), 0.02),
        'ln1_b': nrm(ks[16], (DEPTH, D_MODEL), 0.02),
        'w_gate_up': nrm(ks[17], (DEPTH, D_MODEL, 2 * D_FF), D_MODEL ** -0.5),
        'w_down': nrm(ks[18], (DEPTH, D_FF, D_MODEL), BETA_INIT * D_FF ** -0.5),
        'ln2_g': 1.0 + nrm(ks[19], (DEPTH, D_MODEL), 0.02),
        'ln2_b': nrm(ks[20], (DEPTH, D_MODEL), 0.02),
    }


def reference(x_prompt, x_sample, cache_gdn_conv, state_gdn, state_hgrn, w_in, conv_w, a_log, dt_bias,
              gdn_norm_w, hgrn_lb_logits, hgrn_norm_w, w_br_a, w_br_b, w_out, ln1_g, ln1_b, w_gate_up,
              w_down, ln2_g, ln2_b):
    B = x_prompt.shape[0]
    dt = x_prompt.dtype
    lb_all = jnp.cumsum(jax.nn.softmax(hgrn_lb_logits.astype(jnp.float32), axis=0), axis=0)
    zero_conv = jnp.zeros((B, CONV_W - 1, CONV_CH), dt)
    zero_gdn = jnp.zeros((B, N_HEADS_A, DK_A, DV_A), dt)
    zero_hgrn = jnp.zeros((B, N_HEADS_B, DK_B, DV_B), dt)
    y_prompt, y_sample = x_prompt, x_sample
    conv_p, gdn_p, hgrn_p, conv_s, gdn_s, hgrn_s = [], [], [], [], [], []
    for l in range(DEPTH):
        wl = (w_in[l], conv_w[l], a_log[l], dt_bias[l], gdn_norm_w[l], lb_all[l].reshape(N_HEADS_B, DK_B),
              hgrn_norm_w[l], w_br_a[l], w_br_b[l], w_out[l], ln1_g[l], ln1_b[l], w_gate_up[l], w_down[l],
              ln2_g[l], ln2_b[l])
        y_prompt, cp, gp, hp = _layer(y_prompt, zero_conv, zero_gdn, zero_hgrn, *wl)
        y_sample, cs, gs, hs = _layer(y_sample, cache_gdn_conv[l], state_gdn[l], state_hgrn[l], *wl)
        conv_p.append(cp)
        gdn_p.append(gp)
        hgrn_p.append(hp)
        conv_s.append(cs)
        gdn_s.append(gs)
        hgrn_s.append(hs)
    return (y_prompt, y_sample, jnp.stack(conv_p), jnp.stack(gdn_p), jnp.stack(hgrn_p),
            jnp.stack(conv_s), jnp.stack(gdn_s), jnp.stack(hgrn_s))
```

```cpp
#include <hip/hip_runtime.h>
#include <hip/hip_cooperative_groups.h>
#include <cstdio>
namespace cg = cooperative_groups;

#define LAS __attribute__((address_space(3)))
typedef unsigned short bf16_t;
typedef short bf16x8 __attribute__((ext_vector_type(8)));
typedef float f32x4 __attribute__((ext_vector_type(4)));
typedef float f32x16 __attribute__((ext_vector_type(16)));
typedef float f32x2 __attribute__((ext_vector_type(2)));
typedef unsigned u32x4 __attribute__((ext_vector_type(4)));
typedef unsigned u32x2 __attribute__((ext_vector_type(2)));
typedef __bf16 bf16x2_t __attribute__((ext_vector_type(2)));
#define DI __device__ __forceinline__

constexpr int DM = 1024, NBATCH = 32, SEQ = 2048, NSEG = 4, TSEG = 512, MSEG = NBATCH * TSEG;
constexpr int SBATCH = 8, SLEN = 16, SROWS = SBATCH * SLEN;
constexpr int NPJ = 10240; constexpr int NP = 10304;
constexpr int DFF = 2816;
constexpr int C_QA = 0, C_KA = 1024, C_VA = 2048, C_GA = 3072, C_QH = 4096, C_FH = 5120, C_IH = 6144, C_GH = 7168, C_MGA = 8192, C_MGB = 9216;
constexpr int CONVCH = 3072;
constexpr float ALPHA = 1.189207115002721f;
constexpr int MMAX = MSEG + 256;
constexpr int NSLOT = 2048 + 64;

constexpr size_t WS_WIN = 0;
constexpr size_t WS_WGU = WS_WIN + (size_t)NPJ * 1024 * 2;
constexpr size_t WS_WDN = WS_WGU + (size_t)5632 * 1024 * 2;
constexpr size_t WS_WBRA = WS_WDN + (size_t)1024 * 2816 * 2;
constexpr size_t WS_WBRB = WS_WBRA + (size_t)1024 * 1024 * 2;
constexpr size_t WS_WOUT = WS_WBRB + (size_t)1024 * 1024 * 2;
constexpr size_t WS_CONVC = WS_WOUT + (size_t)1024 * 1024 * 2;
constexpr size_t WS_XB = WS_CONVC + (size_t)2 * NBATCH * 3 * CONVCH * 4;
constexpr size_t WS_PROJ = WS_XB + (size_t)(65536 + 256) * 1024 * 2;
constexpr size_t WS_OA = WS_PROJ + (size_t)MMAX * NP * 2;
constexpr size_t WS_OB = WS_OA + (size_t)MMAX * 1024 * 2;
constexpr size_t WS_MERGED = WS_OB + (size_t)MMAX * 1024 * 2;
constexpr size_t WS_SCAN = WS_MERGED + (size_t)MMAX * 1024 * 2;
constexpr size_t GDN_ITEM = 79872, HG_ITEM = 62464;
constexpr int G_WNEG = 0, G_QD = 17408, G_KDT = 34816, G_A = 53248, G_DEC = 62464, G_STAGE = 63488, G_UT = 63488;
constexpr int H_QD = 0, H_KDT = 17408, H_A = 35840, H_DEC = 45056, H_STAGE = 46080, H_UT = 46080;
constexpr int WQ_LD = 136, KA_LD = 72;
constexpr size_t WS_SG = WS_SCAN;
constexpr size_t WS_SH = WS_SG + (size_t)NSLOT * GDN_ITEM;
constexpr size_t WS_LD = WS_SH + (size_t)NSLOT * HG_ITEM;
constexpr size_t WS_RD = WS_LD + (size_t)NSLOT * 4 + 256;
constexpr size_t WS_SCAN_END = WS_RD + (size_t)NSLOT * 512;
constexpr size_t WS_H = WS_SCAN;
constexpr size_t WS_X1F = WS_H + (size_t)MMAX * 1024 * 4;
constexpr size_t WS_X1B = WS_X1F + (size_t)MMAX * 1024 * 4;
constexpr size_t WS_ACT = WS_X1B + (size_t)MMAX * 1024 * 2;
constexpr size_t WS_ALIAS_END = WS_ACT + (size_t)MMAX * DFF * 2;
static_assert(WS_ALIAS_END <= WS_SCAN_END, "alias overflow");
constexpr size_t WS_AB = WS_SCAN_END;
constexpr size_t WS_BAR = WS_AB + (size_t)(65536 + 256) * 16 * 4;
constexpr size_t WS_END = WS_BAR + 16384;

constexpr size_t O_YP = 0;
constexpr size_t O_YS = O_YP + (size_t)NBATCH * SEQ * DM;
constexpr size_t O_CONVP = O_YS + (size_t)SROWS * DM;
constexpr size_t O_GDNP = O_CONVP + (size_t)NBATCH * 3 * CONVCH;
constexpr size_t O_HGP = O_GDNP + (size_t)NBATCH * 8 * 128 * 128;
constexpr size_t O_CONVS = O_HGP + (size_t)NBATCH * 8 * 128 * 128;
constexpr size_t O_GDNS = O_CONVS + (size_t)SBATCH * 3 * CONVCH;
constexpr size_t O_HGS = O_GDNS + (size_t)SBATCH * 8 * 128 * 128;

struct Params {
    const float* x_prompt; const float* x_sample; const float* cache_conv; const float* state_gdn; const float* state_hgrn;
    const float* w_in; const float* conv_w; const float* a_log; const float* dt_bias; const float* gdn_norm_w; const float* lb_logits;
    const float* hgrn_norm_w; const float* w_br_a; const float* w_br_b; const float* w_out; const float* ln1_g; const float* ln1_b;
    const float* w_gate_up; const float* w_down; const float* ln2_g; const float* ln2_b;
    float* out; unsigned char* ws;
    int wave; int pad_;
};

DI float bf2f(bf16_t v) { return __uint_as_float(((unsigned)v) << 16); }
DI unsigned pk2(float a, float b) { f32x2 v = {a, b}; bf16x2_t r = __builtin_convertvector(v, bf16x2_t); return __builtin_bit_cast(unsigned, r); }
DI bf16_t f2bf(float a) { return (bf16_t)(pk2(a, 0.f) & 0xffffu); }
DI u32x4 pk8(const float* v) { u32x4 r; r[0] = pk2(v[0], v[1]); r[1] = pk2(v[2], v[3]); r[2] = pk2(v[4], v[5]); r[3] = pk2(v[6], v[7]); return r; }
DI void unpk8(u32x4 r, float* v) {
#pragma unroll
    for (int i = 0; i < 4; ++i) { v[2 * i] = __uint_as_float(r[i] << 16); v[2 * i + 1] = __uint_as_float(r[i] & 0xffff0000u); }
}
DI float sigmoidf_(float x) { return __builtin_amdgcn_rcpf(1.f + __expf(-x)); }
DI float siluf_(float x) { return x * __builtin_amdgcn_rcpf(1.f + __expf(-x)); }
DI int swz23(int x) { return (x & ~12) | ((x & 4) << 1) | ((x & 8) >> 1); }
DI float shx(float v, int lane, int m) { return __builtin_bit_cast(float, __builtin_amdgcn_ds_bpermute((lane ^ m) << 2, __builtin_bit_cast(int, v))); }
DI float shup(float v, int lane, int o) { const int src = lane >= o ? lane - o : lane; return __builtin_bit_cast(float, __builtin_amdgcn_ds_bpermute(src << 2, __builtin_bit_cast(int, v))); }
DI int crow(int i, int h) { return (i & 3) + 8 * (i >> 2) + 4 * h; }
DI int otid(int wave) { int l; asm volatile("v_mbcnt_lo_u32_b32 %0, -1, 0\n\tv_mbcnt_hi_u32_b32 %0, -1, %0" : "=v"(l)); return wave * 64 + l; }

namespace pg8 {
constexpr int BM = 256, BK = 64, HALF = 128, HTB = HALF * BK * 2, STAGE_BYTES = 8 * HTB, NXCD = 8, WGM = 8;
DI int lds_byte(int r, int c) { const int st = (r >> 4) * 2 + (c >> 5), rr = r & 15, cc = c & 31, ob = rr * 64 + cc * 2; return st * 1024 + (ob ^ (((ob >> 9) & 1) << 5)); }
DI void stage_rc(int b, int& R, int& C) { const int st = b / 1024, sb = b % 1024, swz = sb ^ (((sb >> 9) & 1) << 5); R = (st >> 1) * 16 + swz / 64; C = (st & 1) * 32 + (swz % 64) / 2; }
DI int perm32(int rho) { const int n = rho >> 4, i = rho & 15; return 8 * (i >> 2) + 4 * n + (i & 3); }
struct Unit { int pm, pn, sub; };
struct Gemm { const bf16_t* A; const bf16_t* Bt; const bf16_t* A2; const bf16_t* Bt2; int M, N, K; };
struct Order {
    int nM, nN, nwg, G, c, dual, wave;
    DI void init(int M, int N, int G_, int c_, int dual_) { nM = M / BM; nN = N / BM; nwg = nM * nN; G = G_; c = c_; dual = dual_; }
    DI bool next(int i, Unit& u) const {
        const int it = dual ? (i >> 1) : i;
        const long L = (long)it * G + c; if (L >= nwg) return false;
        int wgid = (int)L; { const int q = nwg / NXCD, r = nwg % NXCD, xcd = wgid % NXCD, off = wgid / NXCD; wgid = (xcd < r ? xcd * (q + 1) : r * (q + 1) + (xcd - r) * q) + off; }
        const int nig = WGM * nN, gid = wgid / nig, fm = gid * WGM, gsz = (nM - fm) < WGM ? (nM - fm) : WGM;
        u.pm = fm + ((wgid % nig) % gsz); u.pn = (wgid % nig) / gsz; u.sub = dual ? (i & 1) : 0; return true;
    }
};

template <class Epi>
DI void gemm_phase(LAS unsigned char* lds, const Gemm g, const Order& S, const Epi& E) {
    const int tid = otid(S.wave), wid = __builtin_amdgcn_readfirstlane(tid >> 6), lane = tid & 63, wr = wid >> 2, wc = wid & 3, fr = lane & 15, fq = lane >> 4;
    const int K = g.K, nt = K / BK;
    unsigned voffA[2], voffB[2];
#pragma unroll
    for (int i = 0; i < 2; ++i) { int R, C; stage_rc(tid * 16 + i * 8192, R, C); const int Rb = Epi::PERM ? ((R & ~31) + perm32(R & 31)) : R;
        voffA[i] = (unsigned)(R * K + C) * 2u; voffB[i] = (unsigned)(Rb * K + C) * 2u; }
    const size_t kstep = (size_t)(BK * 2);
    const size_t hstep = (size_t)HALF * K * 2;
    const size_t tstep = 2 * hstep;
    const unsigned ldsw = (unsigned)wid * 1024u;
    const int aoff = lds_byte(wr * 64 + fr, fq * 8), boff = lds_byte(wc * 32 + fr, fq * 8);
#define PG8_SA(b, h) (((b) * 2 + (h)) * HTB)
#define PG8_SB(b, h) ((4 + (b) * 2 + (h)) * HTB)
#define PG8_STAGE(bufoff, gbase, voff) do { _Pragma("unroll") for (int _i = 0; _i < 2; ++_i) \
        __builtin_amdgcn_global_load_lds((const unsigned*)((const char*)(gbase) + (voff)[_i]), (LAS unsigned*)(lds + (bufoff) + ldsw + _i * 8192), 16, 0, 0); } while (0)
#define PG8_LDA(dst, b, h) do { _Pragma("unroll") for (int m = 0; m < 4; ++m) _Pragma("unroll") for (int k = 0; k < 2; ++k) dst[m][k] = *(const LAS bf16x8*)(lds + PG8_SA(b, h) + aoff + m * 2048 + k * 1024); } while (0)
#define PG8_LDB(dst, b, h) do { _Pragma("unroll") for (int n = 0; n < 2; ++n) _Pragma("unroll") for (int k = 0; k < 2; ++k) dst[n][k] = *(const LAS bf16x8*)(lds + PG8_SB(b, h) + boff + n * 2048 + k * 1024); } while (0)
#define PG8_MMA(ai, bj, At, Bt) do { __builtin_amdgcn_s_setprio(1); _Pragma("unroll") for (int m = 0; m < 4; ++m) _Pragma("unroll") for (int n = 0; n < 2; ++n) _Pragma("unroll") for (int k = 0; k < 2; ++k) \
        acc[ai][bj][m][n] = __builtin_amdgcn_mfma_f32_16x16x32_bf16(Bt[n][k], At[m][k], acc[ai][bj][m][n], 0, 0, 0); __builtin_amdgcn_s_setprio(0); } while (0)
#define PG8_WAIT_V(n) asm volatile("s_waitcnt vmcnt(" #n ")" ::: "memory")
#define PG8_WAIT_L(n) asm volatile("s_waitcnt lgkmcnt(" #n ")" ::: "memory")
#define PG8_BAR __builtin_amdgcn_s_barrier()
#define PG8_SCHED __builtin_amdgcn_sched_barrier(0)
    Unit cur, nxt; int ui = 0;
    if (!S.next(0, cur)) return;
    f32x4 acc[2][2][4][2];
#pragma unroll
    for (int a = 0; a < 2; ++a)
#pragma unroll
        for (int b = 0; b < 2; ++b)
#pragma unroll
            for (int m = 0; m < 4; ++m)
#pragma unroll
                for (int n = 0; n < 2; ++n) acc[a][b][m][n] = (f32x4){0.f, 0.f, 0.f, 0.f};
    bf16x8 At[4][2], B0[2][2], B1[2][2];
    const char* cA = (const char*)(cur.sub ? g.A2 : g.A) + (size_t)cur.pm * tstep; const char* cB = (const char*)(cur.sub ? g.Bt2 : g.Bt) + (size_t)cur.pn * tstep;
    PG8_STAGE(PG8_SB(0, 0), cB, voffB); PG8_STAGE(PG8_SA(0, 0), cA, voffA); PG8_STAGE(PG8_SB(0, 1), cB + hstep, voffB); PG8_STAGE(PG8_SA(0, 1), cA + hstep, voffA);
    if (wr == 1) PG8_BAR;
    PG8_WAIT_V(4); PG8_BAR;
    PG8_STAGE(PG8_SB(1, 0), cB + kstep, voffB); PG8_STAGE(PG8_SA(1, 0), cA + kstep, voffA); PG8_STAGE(PG8_SB(1, 1), cB + hstep + kstep, voffB);
    PG8_WAIT_V(6); PG8_BAR;
    for (;;) {
        const bool has_next = S.next(ui + 1, nxt);
        const char* nA = has_next ? (const char*)(nxt.sub ? g.A2 : g.A) + (size_t)nxt.pm * tstep : cA; const char* nB = has_next ? (const char*)(nxt.sub ? g.Bt2 : g.Bt) + (size_t)nxt.pn * tstep : cB;
        for (int t = 0; t < nt; t += 2) {
            const bool last = (t == nt - 2);
            const char* a1 = cA + (size_t)(t + 1) * kstep;
            const char* a2 = last ? nA : cA + (size_t)(t + 2) * kstep; const char* b2 = last ? nB : cB + (size_t)(t + 2) * kstep;
            const char* a3 = a2 + kstep; const char* b3 = b2 + kstep;
            PG8_LDB(B0, 0, 0); PG8_SCHED; PG8_LDA(At, 0, 0); PG8_STAGE(PG8_SA(1, 1), a1 + hstep, voffA);
            PG8_WAIT_L(8); PG8_BAR; PG8_WAIT_L(0); PG8_MMA(0, 0, At, B0); PG8_BAR; PG8_SCHED;
            PG8_LDB(B1, 0, 1); PG8_STAGE(PG8_SB(0, 0), b2, voffB);
            PG8_BAR; PG8_WAIT_L(0); PG8_MMA(0, 1, At, B1); PG8_BAR;
            PG8_LDA(At, 0, 1); PG8_STAGE(PG8_SA(0, 0), a2, voffA);
            PG8_BAR; PG8_WAIT_L(0); PG8_MMA(1, 0, At, B0); PG8_BAR; PG8_SCHED;
            PG8_STAGE(PG8_SB(0, 1), b2 + hstep, voffB);
            PG8_WAIT_V(6); PG8_BAR; PG8_MMA(1, 1, At, B1); PG8_BAR;
            PG8_LDB(B0, 1, 0); PG8_SCHED; PG8_LDA(At, 1, 0); PG8_STAGE(PG8_SA(0, 1), a2 + hstep, voffA);
            PG8_WAIT_L(8); PG8_BAR; PG8_WAIT_L(0); PG8_MMA(0, 0, At, B0); PG8_BAR; PG8_SCHED;
            PG8_LDB(B1, 1, 1); PG8_STAGE(PG8_SB(1, 0), b3, voffB);
            PG8_BAR; PG8_WAIT_L(0); PG8_MMA(0, 1, At, B1); PG8_BAR;
            PG8_LDA(At, 1, 1); PG8_STAGE(PG8_SA(1, 0), a3, voffA);
            PG8_BAR; PG8_WAIT_L(0); PG8_MMA(1, 0, At, B0); PG8_BAR; PG8_SCHED;
            PG8_STAGE(PG8_SB(1, 1), b3 + hstep, voffB);
            PG8_WAIT_V(6); PG8_BAR; PG8_MMA(1, 1, At, B1); PG8_BAR;
        }
        E(acc, cur, wr, wc, fr, fq);
        if (!has_next) break;
#pragma unroll
        for (int a = 0; a < 2; ++a)
#pragma unroll
            for (int b = 0; b < 2; ++b)
#pragma unroll
                for (int m = 0; m < 4; ++m)
#pragma unroll
                    for (int n = 0; n < 2; ++n) acc[a][b][m][n] = (f32x4){0.f, 0.f, 0.f, 0.f};
        cur = nxt; cA = nA; cB = nB; ++ui;
    }
    PG8_WAIT_V(0);
    if (wr == 0) PG8_BAR;
    PG8_BAR;
#undef PG8_SA
#undef PG8_SB
#undef PG8_STAGE
#undef PG8_LDA
#undef PG8_LDB
#undef PG8_MMA
#undef PG8_WAIT_V
#undef PG8_WAIT_L
#undef PG8_BAR
#undef PG8_SCHED
}
}
using pg8::Unit;

struct EpiProj {
    static constexpr bool PERM = true;
    bf16_t* O;
    DI void operator()(const f32x4 (&acc)[2][2][4][2], const Unit& u, int wr, int wc, int fr, int fq) const {
#pragma unroll
        for (int ai = 0; ai < 2; ++ai)
#pragma unroll
            for (int m = 0; m < 4; ++m) {
                const int row = u.pm * 256 + ai * 128 + wr * 64 + m * 16 + fr;
                bf16_t* rowp = O + (size_t)row * NP + u.pn * 256 + wc * 32 + 8 * fq;
#pragma unroll
                for (int bj = 0; bj < 2; ++bj) {
                    u32x4 r; r[0] = pk2(acc[ai][bj][m][0][0], acc[ai][bj][m][0][1]); r[1] = pk2(acc[ai][bj][m][0][2], acc[ai][bj][m][0][3]);
                    r[2] = pk2(acc[ai][bj][m][1][0], acc[ai][bj][m][1][1]); r[3] = pk2(acc[ai][bj][m][1][2], acc[ai][bj][m][1][3]);
                    *(u32x4*)(rowp + bj * 128) = r;
                }
            }
    }
};
struct EpiMerge {
    static constexpr bool PERM = true;
    const bf16_t* proj; bf16_t* merged;
    DI void operator()(const f32x4 (&acc)[2][2][4][2], const Unit& u, int wr, int wc, int fr, int fq) const {
        const int gbase = u.sub ? C_MGB : C_MGA;
        const int row0 = u.pm * 256 + wr * 64 + fr, col0 = u.pn * 256 + wc * 32 + 8 * fq;
#pragma unroll
        for (int ai = 0; ai < 2; ++ai) {
            u32x4 gv[4][2], pv[4][2];
#pragma unroll
            for (int m = 0; m < 4; ++m)
#pragma unroll
                for (int bj = 0; bj < 2; ++bj) gv[m][bj] = *(const u32x4*)(proj + (size_t)(row0 + ai * 128 + m * 16) * NP + gbase + col0 + bj * 128);
            if (u.sub) {
#pragma unroll
                for (int m = 0; m < 4; ++m)
#pragma unroll
                    for (int bj = 0; bj < 2; ++bj) pv[m][bj] = *(const u32x4*)(merged + (size_t)(row0 + ai * 128 + m * 16) * 1024 + col0 + bj * 128);
            } else {
#pragma unroll
                for (int m = 0; m < 4; ++m)
#pragma unroll
                    for (int bj = 0; bj < 2; ++bj) pv[m][bj] = (u32x4){0u, 0u, 0u, 0u};
            }
#pragma unroll
            for (int m = 0; m < 4; ++m)
#pragma unroll
                for (int bj = 0; bj < 2; ++bj) {
                    float g8[8], p8[8], v[8]; unpk8(gv[m][bj], g8); unpk8(pv[m][bj], p8);
#pragma unroll
                    for (int e = 0; e < 8; ++e) v[e] = sigmoidf_(g8[e]) * acc[ai][bj][m][e >> 2][e & 3] + p8[e];
                    *(u32x4*)(merged + (size_t)(row0 + ai * 128 + m * 16) * 1024 + col0 + bj * 128) = pk8(v);
                }
        }
    }
};
struct EpiRes {
    static constexpr bool PERM = false;
    const bf16_t* resb; bf16_t* out;
    DI void operator()(const f32x4 (&acc)[2][2][4][2], const Unit& u, int wr, int wc, int fr, int fq) const {
        const int row0 = u.pm * 256 + wr * 64 + fr, col0 = u.pn * 256 + wc * 32 + 4 * fq;
#pragma unroll
        for (int ai = 0; ai < 2; ++ai) {
            u32x2 rb[4][2][2];
#pragma unroll
            for (int m = 0; m < 4; ++m)
#pragma unroll
                for (int bj = 0; bj < 2; ++bj)
#pragma unroll
                    for (int n = 0; n < 2; ++n) rb[m][bj][n] = *(const u32x2*)(resb + (size_t)(row0 + ai * 128 + m * 16) * 1024 + col0 + bj * 128 + 16 * n);
#pragma unroll
            for (int m = 0; m < 4; ++m)
#pragma unroll
                for (int bj = 0; bj < 2; ++bj)
#pragma unroll
                    for (int n = 0; n < 2; ++n) {
                        const u32x2 w0 = rb[m][bj][n];
                        const f32x4 r = {__uint_as_float(w0[0] << 16), __uint_as_float(w0[0] & 0xffff0000u), __uint_as_float(w0[1] << 16), __uint_as_float(w0[1] & 0xffff0000u)};
                        const f32x4 v = r * ALPHA + acc[ai][bj][m][n];
                        u32x2 w; w[0] = pk2(v[0], v[1]); w[1] = pk2(v[2], v[3]);
                        *(u32x2*)(out + (size_t)(row0 + ai * 128 + m * 16) * 1024 + col0 + bj * 128 + 16 * n) = w;
                    }
        }
    }
};
struct EpiSwiglu {
    static constexpr bool PERM = true;
    bf16_t* act;
    DI void operator()(const f32x4 (&acc)[2][2][4][2], const Unit& u, int wr, int wc, int fr, int fq) const {
#pragma unroll
        for (int ai = 0; ai < 2; ++ai)
#pragma unroll
            for (int m = 0; m < 4; ++m) {
                const int row = u.pm * 256 + ai * 128 + wr * 64 + m * 16 + fr;
                float v[8];
#pragma unroll
                for (int e = 0; e < 8; ++e) v[e] = siluf_(acc[ai][0][m][e >> 2][e & 3]) * acc[ai][1][m][e >> 2][e & 3];
                *(u32x4*)(act + (size_t)row * DFF + u.pn * 128 + wc * 32 + 8 * fq) = pk8(v);
            }
    }
};

DI int mapcol(int mode, int n) {
    if (mode == 0) return n;
    if (mode == 1) return n < 4096 ? n : n + 16;
    const int t = n >> 8, w = n & 255; return w < 128 ? t * 128 + w : DFF + t * 128 + (w - 128);
}
DI void transpose_tile(const float* src, bf16_t* dst, int K, int Nsrc, int mode, int k0, int n0, float* tile, int wave) {
    const int tid = otid(wave), tx = tid & 63, ty = tid >> 6;
    const int sc = mapcol(mode, n0 + tx);
#pragma unroll
    for (int kk = 0; kk < 8; ++kk) { const int kl = ty * 8 + kk; tile[kl * 65 + tx] = sc >= 0 ? src[(size_t)(k0 + kl) * Nsrc + sc] : 0.f; }
    __syncthreads();
    const int nl = tid >> 3, ks = tid & 7;
    float v[8];
#pragma unroll
    for (int j = 0; j < 8; ++j) v[j] = tile[(ks * 8 + j) * 65 + nl];
    *(u32x4*)(dst + (size_t)(n0 + nl) * K + k0 + ks * 8) = pk8(v);
    __syncthreads();
}
DI void phase0(const Params& p, float* ldsf) {
    unsigned char* ws = p.ws;
    int base = 0;
#pragma unroll
    for (int j = 0; j < 6; ++j) {
        const float* src = j == 0 ? p.w_in : j == 1 ? p.w_gate_up : j == 2 ? p.w_down : j == 3 ? p.w_br_a : j == 4 ? p.w_br_b : p.w_out;
        bf16_t* dst = (bf16_t*)(ws + (j == 0 ? WS_WIN : j == 1 ? WS_WGU : j == 2 ? WS_WDN : j == 3 ? WS_WBRA : j == 4 ? WS_WBRB : WS_WOUT));
        const int K = j == 2 ? DFF : 1024, Nsrc = j == 0 ? 10256 : j == 1 ? 5632 : 1024, mode = j == 0 ? 1 : j == 1 ? 2 : 0;
        const int nkj = j == 2 ? 44 : 16, nnj = j == 0 ? 160 : j == 1 ? 88 : 16;
        const int ntile = nkj * nnj;
        for (int t = ((int)blockIdx.x + (int)gridDim.x - (base % (int)gridDim.x)) % (int)gridDim.x; t < ntile; t += gridDim.x)
            transpose_tile(src, dst, K, Nsrc, mode, (t % nkj) * 64, (t / nkj) * 64, ldsf, p.wave);
        base += ntile;
    }
    __syncthreads();
    {
        const int tid = otid(p.wave), lane = tid & 63, wid = tid >> 6, r = lane & 15, q4 = lane >> 4;
        bf16_t* wsm = (bf16_t*)ldsf;
        for (int idx = tid; idx < 16384; idx += 512) { const int k = idx >> 4, n = idx & 15; wsm[n * 1032 + k] = f2bf(p.w_in[(size_t)k * 10256 + 4096 + n]); }
        __syncthreads();
        bf16_t* xb = (bf16_t*)(ws + WS_XB); float* ab = (float*)(ws + WS_AB);
        for (int task = (int)blockIdx.x * 8 + wid; task < (65536 + 256) / 16; task += (int)gridDim.x * 8) {
            const int d = task * 16 + r;
            const float* src;
            if (d < 65536) { const int sg = d >> 14, rem = d & 16383, b = rem >> 9, tl = rem & 511; src = p.x_prompt + ((size_t)b * SEQ + sg * TSEG + tl) * 1024; }
            else if (d < 65536 + SROWS) src = p.x_sample + (size_t)(d - 65536) * 1024;
            else src = nullptr;
            f32x4 acc = {0.f, 0.f, 0.f, 0.f};
#pragma unroll 1
            for (int kb = 0; kb < 4; ++kb) {
                f32x4 a[8], bq[8];
#pragma unroll
                for (int i = 0; i < 8; ++i) {
                    const int k0 = 32 * (8 * kb + i) + 8 * q4;
                    a[i] = (f32x4){0.f, 0.f, 0.f, 0.f}; bq[i] = (f32x4){0.f, 0.f, 0.f, 0.f};
                    if (src) { a[i] = *(const f32x4*)(src + k0); bq[i] = *(const f32x4*)(src + k0 + 4); }
                }
#pragma unroll
                for (int i = 0; i < 8; ++i) {
                    const int k0 = 32 * (8 * kb + i) + 8 * q4;
                    u32x4 pk; pk[0] = pk2(a[i][0], a[i][1]); pk[1] = pk2(a[i][2], a[i][3]); pk[2] = pk2(bq[i][0], bq[i][1]); pk[3] = pk2(bq[i][2], bq[i][3]);
                    *(u32x4*)(xb + (size_t)d * 1024 + k0) = pk;
                    const bf16x8 wf = *(const bf16x8*)(wsm + r * 1032 + k0);
                    acc = __builtin_amdgcn_mfma_f32_16x16x32_bf16(__builtin_bit_cast(bf16x8, pk), wf, acc, 0, 0, 0);
                }
            }
#pragma unroll
            for (int jj = 0; jj < 4; ++jj) ab[(size_t)(task * 16 + 4 * q4 + jj) * 16 + r] = acc[jj];
        }
    }
}

DI void ln_phase(const Params& p, int seg, int mode) {
    const int tid_ = otid(p.wave); const int lane = tid_ & 63, wid = tid_ >> 6;
    const int nrows = MSEG + (seg == NSEG - 1 ? SROWS : 0);
    const bf16_t* H = (const bf16_t*)(p.ws + WS_H);
    const float* gam = mode == 0 ? p.ln1_g : p.ln2_g; const float* bet = mode == 0 ? p.ln1_b : p.ln2_b;
    f32x4 g4[4], b4[4];
#pragma unroll
    for (int j = 0; j < 4; ++j) { g4[j] = *(const f32x4*)(gam + lane * 4 + 256 * j); b4[j] = *(const f32x4*)(bet + lane * 4 + 256 * j); }
    for (int row = (int)blockIdx.x * 8 + wid; row < nrows; row += (int)gridDim.x * 8) {
        const bf16_t* src = H + (size_t)row * 1024;
        f32x4 v[4]; float s = 0.f;
#pragma unroll
        for (int j = 0; j < 4; ++j) { const u32x2 rb = *(const u32x2*)(src + lane * 4 + 256 * j);
            v[j] = (f32x4){__uint_as_float(rb[0] << 16), __uint_as_float(rb[0] & 0xffff0000u), __uint_as_float(rb[1] << 16), __uint_as_float(rb[1] & 0xffff0000u)};
            s += (v[j][0] + v[j][1]) + (v[j][2] + v[j][3]); }
#pragma unroll
        for (int o = 1; o < 64; o <<= 1) s += shx(s, lane, o);
        const float mu = s * (1.f / 1024.f);
        float q = 0.f;
#pragma unroll
        for (int j = 0; j < 4; ++j) { v[j] = v[j] - mu; q += (v[j][0] * v[j][0] + v[j][1] * v[j][1]) + (v[j][2] * v[j][2] + v[j][3] * v[j][3]); }
#pragma unroll
        for (int o = 1; o < 64; o <<= 1) q += shx(q, lane, o);
        const float rstd = rsqrtf(q * (1.f / 1024.f) + 1e-5f);
        if (mode == 0) {
            bf16_t* o2 = (bf16_t*)(p.ws + WS_X1B) + (size_t)row * 1024;
#pragma unroll
            for (int j = 0; j < 4; ++j) { const f32x4 y = v[j] * rstd * g4[j] + b4[j];
                u32x2 r; r[0] = pk2(y[0], y[1]); r[1] = pk2(y[2], y[3]); *(u32x2*)(o2 + lane * 4 + 256 * j) = r; }
        } else {
            float* o1 = row < MSEG ? p.out + O_YP + ((size_t)(row >> 9) * SEQ + seg * TSEG + (row & 511)) * 1024 : p.out + O_YS + (size_t)(row - MSEG) * 1024;
#pragma unroll
            for (int j = 0; j < 4; ++j) { const f32x4 y = v[j] * rstd * g4[j] + b4[j]; *(f32x4*)(o1 + lane * 4 + 256 * j) = y; }
        }
    }
}

constexpr int LQ = 0, LK = 8448, LV = 16896, LL = 25344, LMISC = 29696, LW = 29952;

DI bf16x8 ldsf32_frag(const float* p) {
    const f32x4 a = *(const f32x4*)p, b = *(const f32x4*)(p + 4);
    u32x4 r; r[0] = pk2(a[0], a[1]); r[1] = pk2(a[2], a[3]); r[2] = pk2(b[0], b[1]); r[3] = pk2(b[2], b[3]);
    return __builtin_bit_cast(bf16x8, r);
}
DI void pair_of(int pr, int& I, int& J) { I = 0; int rem = pr; while (rem > I) { rem -= I + 1; ++I; } J = rem; }

struct GdnPre { u32x4 raw[11]; f32x4 wt[4][2]; float aa, ba; };
DI void gdn_b1_load(const Params& p, int seg, int slot, GdnPre& pre) {
    const int tid = otid(p.wave);
    const bool smp = slot >= 2048;
    int b, h, c, row0, nvalid;
    if (!smp) { const int bh = slot >> 3; c = slot & 7; b = bh >> 3; h = bh & 7; row0 = b * TSEG + c * 64; nvalid = 64; }
    else { const int s2 = slot - 2048; b = s2 >> 3; h = s2 & 7; c = 0; row0 = MSEG + b * SLEN; nvalid = SLEN; }
    const bf16_t* proj = (const bf16_t*)(p.ws + WS_PROJ);
    if (tid < 384) {
        const int ch8 = tid & 15, run = (tid >> 4) & 7, tensor = tid >> 7;
        const int col = tensor * 1024 + h * 128 + ch8 * 8, i0 = run * 8;
        const bf16_t* convc_prev = (const bf16_t*)(p.ws + WS_CONVC) + (size_t)((seg + 1) & 1) * NBATCH * 3 * CONVCH;
#pragma unroll
        for (int j = 0; j < 11; ++j) {
            const int ii = i0 - 3 + j;
            if (j >= 3 || run > 0 || (!smp && c > 0)) pre.raw[j] = *(const u32x4*)(proj + (size_t)(row0 + ii) * NP + col);
            else if (smp) { const float* sp = p.cache_conv + ((size_t)b * 3 + j) * CONVCH + col; const f32x4 a = *(const f32x4*)sp, bb = *(const f32x4*)(sp + 4);
                u32x4 r; r[0] = pk2(a[0], a[1]); r[1] = pk2(a[2], a[3]); r[2] = pk2(bb[0], bb[1]); r[3] = pk2(bb[2], bb[3]); pre.raw[j] = r; }
            else if (seg > 0) pre.raw[j] = *(const u32x4*)(convc_prev + ((size_t)b * 3 + j) * CONVCH + col);
            else pre.raw[j] = (u32x4){0u, 0u, 0u, 0u};
        }
#pragma unroll
        for (int d = 0; d < 4; ++d) { const float* wv = p.conv_w + (size_t)d * CONVCH + col; pre.wt[d][0] = *(const f32x4*)wv; pre.wt[d][1] = *(const f32x4*)(wv + 4); }
    } else if (tid < 448) {
        const int i = tid - 384;
        pre.aa = 0.f; pre.ba = 0.f;
        if (i < nvalid) { const float* abp = (const float*)(p.ws + WS_AB) + ((size_t)seg * MSEG + row0 + i) * 16; pre.aa = abp[h]; pre.ba = abp[8 + h]; }
    }
}

DI void gdn_b1_item(const Params& p, int seg, int slot, float* lds, GdnPre& pre, int next_slot) {
    const int tid = otid(p.wave), lane = tid & 63, wid = tid >> 6;
    const bool smp = slot >= 2048;
    int b, h, c, row0, nvalid;
    if (!smp) { const int bh = slot >> 3; c = slot & 7; b = bh >> 3; h = bh & 7; row0 = b * TSEG + c * 64; nvalid = 64; }
    else { const int s2 = slot - 2048; b = s2 >> 3; h = s2 & 7; c = 0; row0 = MSEG + b * SLEN; nvalid = SLEN; }
    float* Q = lds + LQ; float* Kk = lds + LK; float* V = lds + LV; float* Lm = lds + LL; float* misc = lds + LMISC; float* W = lds + LW;
    unsigned char* ib = p.ws + WS_SG + (size_t)slot * GDN_ITEM;
    bf16_t* o_wneg = (bf16_t*)(ib + G_WNEG); bf16_t* o_qd = (bf16_t*)(ib + G_QD); bf16_t* o_kdT = (bf16_t*)(ib + G_KDT); bf16_t* o_A = (bf16_t*)(ib + G_A); bf16_t* o_uT = (bf16_t*)(ib + G_UT);
    if (tid < 384) {
        const int ch8 = tid & 15, run = (tid >> 4) & 7, tensor = tid >> 7;
        const int col = tensor * 1024 + h * 128 + ch8 * 8, i0 = run * 8;
        bf16_t* convc_cur = (bf16_t*)(p.ws + WS_CONVC) + (size_t)(seg & 1) * NBATCH * 3 * CONVCH;
        u32x4 (&raw)[11] = pre.raw; f32x4 (&wt)[4][2] = pre.wt;
        float y[8][8];
#pragma unroll
        for (int n = 0; n < 8; ++n)
#pragma unroll
            for (int e = 0; e < 8; ++e) y[n][e] = 0.f;
#pragma unroll
        for (int j = 0; j < 11; ++j) {
            float u[8]; unpk8(raw[j], u);
#pragma unroll
            for (int d = 0; d < 4; ++d) {
                const int n = j - 3 + d;
                if (n >= 0 && n < 8) {
#pragma unroll
                    for (int e = 0; e < 8; ++e) y[n][e] += wt[3 - d][e >> 2][e & 3] * u[e];
                }
            }
        }
        if (run == (nvalid >> 3) - 1 && (smp || c == 7)) {
#pragma unroll
            for (int j = 0; j < 3; ++j) {
                float u[8]; unpk8(raw[8 + j], u);
                const f32x4 a = {u[0], u[1], u[2], u[3]}, bb = {u[4], u[5], u[6], u[7]};
                if (smp) { float* o = p.out + O_CONVS + ((size_t)b * 3 + j) * CONVCH + col; *(f32x4*)o = a; *(f32x4*)(o + 4) = bb; }
                else {
                    *(u32x4*)(convc_cur + ((size_t)b * 3 + j) * CONVCH + col) = raw[8 + j];
                    if (seg == NSEG - 1) { float* o2 = p.out + O_CONVP + ((size_t)b * 3 + j) * CONVCH + col; *(f32x4*)o2 = a; *(f32x4*)(o2 + 4) = bb; }
                }
            }
        }
        float* dstb = (tensor == 0 ? Q : tensor == 1 ? Kk : V) + ch8 * 8;
#pragma unroll
        for (int n = 0; n < 8; ++n) {
            const bool ok = i0 + n < nvalid;
#pragma unroll
            for (int e = 0; e < 8; ++e) y[n][e] = ok ? siluf_(y[n][e]) : 0.f;
            if (tensor < 2) {
                float ss = 0.f;
#pragma unroll
                for (int e = 0; e < 8; ++e) ss += y[n][e] * y[n][e];
                ss += shx(ss, lane, 1); ss += shx(ss, lane, 2); ss += shx(ss, lane, 4); ss += shx(ss, lane, 8);
                float rs = rsqrtf(ss + 1e-6f); if (tensor == 0) rs *= 0.08838834764831845f;
#pragma unroll
                for (int e = 0; e < 8; ++e) y[n][e] *= rs;
            }
            float* dst = dstb + (i0 + n) * 132;
            *(f32x4*)dst = (f32x4){y[n][0], y[n][1], y[n][2], y[n][3]}; *(f32x4*)(dst + 4) = (f32x4){y[n][4], y[n][5], y[n][6], y[n][7]};
        }
    } else if (tid < 448) {
        const int i = tid - 384;
        float g = 0.f, be = 0.f;
        if (i < nvalid) {
            const float xx = pre.aa + p.dt_bias[h];
            const float sp = fmaxf(xx, 0.f) + __logf(1.f + __expf(-fabsf(xx)));
            g = -__expf(p.a_log[h]) * sp; be = sigmoidf_(pre.ba);
        }
        float x = g;
#pragma unroll
        for (int o = 1; o < 64; o <<= 1) { const float yv = shup(x, lane, o); if (lane >= o) x += yv; }
        misc[i] = g; misc[64 + i] = be; misc[128 + i] = x; misc[192 + i] = __expf(x);
    }
    gdn_b1_load(p, seg, next_slot, pre);
    __syncthreads();
    for (int tl = wid; tl < 20; tl += 8) {
        const int which = tl >= 10; int I, J; pair_of(which ? tl - 10 : tl, I, J);
        const int r = lane & 15, q4 = lane >> 4;
        const float* X = which ? Q : Kk;
        f32x4 acc = {0.f, 0.f, 0.f, 0.f};
#pragma unroll
        for (int ks = 0; ks < 4; ++ks) {
            const int k0 = 32 * ks + 8 * q4;
            acc = __builtin_amdgcn_mfma_f32_16x16x32_bf16(ldsf32_frag(X + (16 * I + r) * 132 + k0), ldsf32_frag(Kk + (16 * J + r) * 132 + k0), acc, 0, 0, 0);
        }
        const int s = 16 * J + r;
#pragma unroll
        for (int jj = 0; jj < 4; ++jj) {
            const int t = 16 * I + 4 * q4 + jj;
            const float dec = __expf(fminf(misc[128 + t] - misc[128 + s], 0.f));
            if (!which) Lm[t * 68 + s] = (s < t) ? misc[64 + t] * acc[jj] * dec : 0.f;
            else o_A[t * KA_LD + swz23(s)] = f2bf((s <= t) ? acc[jj] * dec : 0.f);
        }
    }
    {
        const int pr = tid >> 8, e = tid & 255, I = pr ? 2 : 0, J = I + 1;
        o_A[(16 * I + (e >> 4)) * KA_LD + swz23(16 * J + (e & 15))] = 0;
    }
    __syncthreads();
    if (tid < 256) {
        f32x2 x2[32];
        LAS float* colp = (LAS float*)(tid < 128 ? V + tid : Kk + (tid - 128));
        LAS float* outp = (LAS float*)(tid < 128 ? V + tid : W + (tid - 128));
        const LAS float* Lb = (const LAS float*)Lm; const LAS float* mb = (const LAS float*)misc;
        asm volatile("" : "+v"(Lb), "+v"(mb), "+v"(colp), "+v"(outp));
#pragma unroll
        for (int t = 0; t < 64; ++t) { float v = colp[t * 132] * mb[64 + t]; if (tid >= 128) v *= mb[192 + t]; x2[t >> 1][t & 1] = v; }
#pragma unroll
        for (int t = 1; t < 64; ++t) {
            f32x2 a01 = {0.f, 0.f}, a23 = {0.f, 0.f};
#pragma unroll
            for (int s4 = 0; s4 < (t + 3) / 4; ++s4) {
                const f32x4 l = *(const LAS f32x4*)(Lb + t * 68 + 4 * s4);
                a01 = __builtin_elementwise_fma((f32x2){l[0], l[1]}, x2[2 * s4], a01);
                a23 = __builtin_elementwise_fma((f32x2){l[2], l[3]}, x2[2 * s4 + 1], a23);
            }
            const f32x2 a = a01 + a23;
            x2[t >> 1][t & 1] -= a[0] + a[1];
        }
        const float sg = tid < 128 ? 1.f : -1.f;
#pragma unroll
        for (int t = 0; t < 64; ++t) outp[t * 132] = sg * x2[t >> 1][t & 1];
    } else {
        const int tg = tid - 256;
#pragma unroll
        for (int j = 0; j < 4; ++j) {
            const int uu = tg + 256 * j, t = uu >> 4, gh = uu & 15, G = gh >> 1, hh = gh & 1;
            const float sc = misc[192 + t];
            const f32x4 a = *(const f32x4*)(Q + t * 132 + 16 * G + 4 * hh), bb = *(const f32x4*)(Q + t * 132 + 16 * G + 8 + 4 * hh);
            float v[8] = {a[0] * sc, a[1] * sc, a[2] * sc, a[3] * sc, bb[0] * sc, bb[1] * sc, bb[2] * sc, bb[3] * sc};
            *(u32x4*)(o_qd + t * WQ_LD + 16 * G + 8 * hh) = pk8(v);
        }
        const float gl = misc[128 + 63];
#pragma unroll
        for (int j = 0; j < 4; ++j) {
            const int uu = tg + 256 * j, dk = uu & 127, gh = uu >> 7, G = gh >> 1, hh = gh & 1;
            float v[8];
#pragma unroll
            for (int e = 0; e < 8; ++e) { const int t = 16 * G + 8 * (e >> 2) + 4 * hh + (e & 3); v[e] = Kk[t * 132 + dk] * __expf(gl - misc[128 + t]); }
            *(u32x4*)(o_kdT + dk * KA_LD + 16 * G + 8 * hh) = pk8(v);
        }
        if (tg == 0) *(float*)(ib + G_DEC) = __expf(gl);
    }
    __syncthreads();
#pragma unroll
    for (int j = 0; j < 2; ++j) {
        const int uu = tid + 512 * j, t = uu >> 4, gh = uu & 15, G = gh >> 1, hh = gh & 1;
        const f32x4 a = *(const f32x4*)(W + t * 132 + 16 * G + 4 * hh), bb = *(const f32x4*)(W + t * 132 + 16 * G + 8 + 4 * hh);
        float v[8] = {a[0], a[1], a[2], a[3], bb[0], bb[1], bb[2], bb[3]};
        *(u32x4*)(o_wneg + t * WQ_LD + 16 * G + 8 * hh) = pk8(v);
    }
#pragma unroll
    for (int j = 0; j < 2; ++j) {
        const int uu = tid + 512 * j, dv = uu & 127, t8 = uu >> 7;
        float v[8];
#pragma unroll
        for (int e = 0; e < 8; ++e) v[e] = V[(t8 * 8 + e) * 132 + dv];
        *(u32x4*)(o_uT + dv * 64 + t8 * 8) = pk8(v);
    }
    __syncthreads();
}

struct HgPre { u32x4 qraw[2], zraw[2]; f32x4 l0[2][2], l1[2][2]; unsigned short vt[2][8]; };
DI void hgrn_b1_load(const Params& p, int seg, int slot, HgPre& pre) {
    const int tid = otid(p.wave);
    const bool smp = slot >= 2048;
    int b, h, row0, nvalid;
    if (!smp) { const int bh = slot >> 3, c = slot & 7; b = bh >> 3; h = bh & 7; row0 = b * TSEG + c * 64; nvalid = 64; }
    else { const int s2 = slot - 2048; b = s2 >> 3; h = s2 & 7; row0 = MSEG + b * SLEN; nvalid = SLEN; }
    const bf16_t* proj = (const bf16_t*)(p.ws + WS_PROJ);
#pragma unroll
    for (int j = 0; j < 2; ++j) {
        const int uu = tid + 512 * j, dv = uu & 127, t8 = uu >> 7;
#pragma unroll
        for (int e = 0; e < 8; ++e) { const int t = t8 * 8 + e; pre.vt[j][e] = t < nvalid ? proj[(size_t)(row0 + t) * NP + C_IH + h * 128 + dv] : (unsigned short)0; }
    }
#pragma unroll
    for (int j = 0; j < 2; ++j) {
        const int uu = tid + 512 * j, i = uu >> 4, ch8 = uu & 15, ch = h * 128 + ch8 * 8;
        const int ic = i < nvalid ? i : 0;
        pre.qraw[j] = *(const u32x4*)(proj + (size_t)(row0 + ic) * NP + C_QH + ch);
        pre.zraw[j] = *(const u32x4*)(proj + (size_t)(row0 + ic) * NP + C_FH + ch);
        pre.l0[j][0] = *(const f32x4*)(p.lb_logits + ch); pre.l0[j][1] = *(const f32x4*)(p.lb_logits + ch + 4);
        pre.l1[j][0] = *(const f32x4*)(p.lb_logits + 1024 + ch); pre.l1[j][1] = *(const f32x4*)(p.lb_logits + 1024 + ch + 4);
    }
}

DI void hgrn_b1_item(const Params& p, int seg, int slot, float* lds, HgPre& pre, int next_slot) {
    const int tid = otid(p.wave), lane = tid & 63, wid = tid >> 6;
    const bool smp = slot >= 2048;
    int b, h, row0, nvalid;
    if (!smp) { const int bh = slot >> 3, c = slot & 7; b = bh >> 3; h = bh & 7; row0 = b * TSEG + c * 64; nvalid = 64; }
    else { const int s2 = slot - 2048; b = s2 >> 3; h = s2 & 7; row0 = MSEG + b * SLEN; nvalid = SLEN; }
    float* Q = lds + LQ; float* Kk = lds + LK; float* Bl = lds + LV; float* Tot = lds + LL;
    unsigned char* ib = p.ws + WS_SH + (size_t)slot * HG_ITEM;
    bf16_t* o_qd = (bf16_t*)(ib + H_QD); bf16_t* o_kdT = (bf16_t*)(ib + H_KDT); bf16_t* o_A = (bf16_t*)(ib + H_A); bf16_t* o_uT = (bf16_t*)(ib + H_UT);
    {
#pragma unroll
        for (int j = 0; j < 2; ++j) {
            const int uu = tid + 512 * j, i = uu >> 4, ch8 = uu & 15;
            float q[8], k[8], lf[8];
            if (i < nvalid) {
                float qv[8], zv[8];
                unpk8(pre.qraw[j], qv); unpk8(pre.zraw[j], zv);
#pragma unroll
                for (int e = 0; e < 8; ++e) {
                    const float l0 = pre.l0[j][e >> 2][e & 3], l1 = pre.l1[j][e >> 2][e & 3];
                    const float lbv = __builtin_amdgcn_rcpf(1.f + __expf(l1 - l0));
                    const float sg = sigmoidf_(zv[e]);
                    const float f = lbv + (1.f - lbv) * sg;
                    q[e] = siluf_(qv[e]) * 0.08838834764831845f; k[e] = (1.f - lbv) * (1.f - sg); lf[e] = __logf(f);
                }
            } else {
#pragma unroll
                for (int e = 0; e < 8; ++e) { q[e] = 0.f; k[e] = 0.f; lf[e] = 0.f; }
            }
            *(f32x4*)(Q + i * 132 + ch8 * 8) = (f32x4){q[0], q[1], q[2], q[3]}; *(f32x4*)(Q + i * 132 + ch8 * 8 + 4) = (f32x4){q[4], q[5], q[6], q[7]};
            *(f32x4*)(Kk + i * 132 + ch8 * 8) = (f32x4){k[0], k[1], k[2], k[3]}; *(f32x4*)(Kk + i * 132 + ch8 * 8 + 4) = (f32x4){k[4], k[5], k[6], k[7]};
            *(f32x4*)(Bl + i * 132 + ch8 * 8) = (f32x4){lf[0], lf[1], lf[2], lf[3]}; *(f32x4*)(Bl + i * 132 + ch8 * 8 + 4) = (f32x4){lf[4], lf[5], lf[6], lf[7]};
        }
#pragma unroll
        for (int j = 0; j < 2; ++j) { const int uu = tid + 512 * j, dv = uu & 127, t8 = uu >> 7;
            u32x4 w;
#pragma unroll
            for (int e2 = 0; e2 < 4; ++e2) w[e2] = (unsigned)pre.vt[j][2 * e2] | ((unsigned)pre.vt[j][2 * e2 + 1] << 16);
            *(u32x4*)(o_uT + dv * 64 + t8 * 8) = w; }
    }
    hgrn_b1_load(p, seg, next_slot, pre);
    __syncthreads();
    { const int ch = tid & 127, I = tid >> 7; float sacc = 0.f;
#pragma unroll
        for (int j = 0; j < 16; ++j) { sacc += Bl[(16 * I + j) * 132 + ch]; Bl[(16 * I + j) * 132 + ch] = sacc; }
        Tot[I * 128 + ch] = sacc; }
    __syncthreads();
#pragma unroll
    for (int j = 0; j < 2; ++j) {
        const int uu = tid + 512 * j, t = uu >> 4, gh = uu & 15, G = gh >> 1, hh = gh & 1, I = t >> 4;
        const int c0 = 16 * G + 4 * hh, c1 = c0 + 8;
        f32x4 B0 = {0.f, 0.f, 0.f, 0.f}, B1 = {0.f, 0.f, 0.f, 0.f};
        for (int jj = 0; jj < I; ++jj) { B0 += *(const f32x4*)(Tot + jj * 128 + c0); B1 += *(const f32x4*)(Tot + jj * 128 + c1); }
        const f32x4 a = *(const f32x4*)(Q + t * 132 + c0), bb = *(const f32x4*)(Q + t * 132 + c1), ea = *(const f32x4*)(Bl + t * 132 + c0) + B0, eb = *(const f32x4*)(Bl + t * 132 + c1) + B1;
        float v[8] = {a[0] * __expf(ea[0]), a[1] * __expf(ea[1]), a[2] * __expf(ea[2]), a[3] * __expf(ea[3]), bb[0] * __expf(eb[0]), bb[1] * __expf(eb[1]), bb[2] * __expf(eb[2]), bb[3] * __expf(eb[3])};
        *(u32x4*)(o_qd + t * WQ_LD + 16 * G + 8 * hh) = pk8(v);
    }
#pragma unroll
    for (int j = 0; j < 2; ++j) {
        const int uu = tid + 512 * j, dk = uu & 127, gh = uu >> 7, G = gh >> 1, hh = gh & 1;
        float rest = Tot[G * 128 + dk];
        for (int jj = G + 1; jj < 4; ++jj) rest += Tot[jj * 128 + dk];
        float v[8];
#pragma unroll
        for (int e = 0; e < 8; ++e) { const int t = 16 * G + 8 * (e >> 2) + 4 * hh + (e & 3); v[e] = Kk[t * 132 + dk] * __expf(rest - Bl[t * 132 + dk]); }
        *(u32x4*)(o_kdT + dk * KA_LD + 16 * G + 8 * hh) = pk8(v);
    }
    if (tid < 128) ((float*)(ib + H_DEC))[tid] = __expf((Tot[tid] + Tot[128 + tid]) + (Tot[256 + tid] + Tot[384 + tid]));
    for (int pr = wid; pr < 10; pr += 8) {
        int I, J; pair_of(pr, I, J);
        const int r = lane & 15, q4 = lane >> 4;
        f32x4 acc = {0.f, 0.f, 0.f, 0.f};
#pragma unroll
        for (int ks = 0; ks < 4; ++ks) {
            const int k0 = 32 * ks + 8 * q4;
            float av[8], bv[8];
#pragma unroll
            for (int e4 = 0; e4 < 2; ++e4) {
                f32x4 dd = {0.f, 0.f, 0.f, 0.f};
                for (int jj = J; jj < I; ++jj) dd += *(const f32x4*)(Tot + jj * 128 + k0 + 4 * e4);
                const f32x4 qv = *(const f32x4*)(Q + (16 * I + r) * 132 + k0 + 4 * e4), ql = *(const f32x4*)(Bl + (16 * I + r) * 132 + k0 + 4 * e4);
                const f32x4 kv = *(const f32x4*)(Kk + (16 * J + r) * 132 + k0 + 4 * e4), kl = *(const f32x4*)(Bl + (16 * J + r) * 132 + k0 + 4 * e4);
#pragma unroll
                for (int e = 0; e < 4; ++e) { av[4 * e4 + e] = qv[e] * __expf(ql[e] + dd[e]); bv[4 * e4 + e] = kv[e] * __expf(-kl[e]); }
            }
            const bf16x8 a = __builtin_bit_cast(bf16x8, pk8(av)), bb = __builtin_bit_cast(bf16x8, pk8(bv));
            acc = __builtin_amdgcn_mfma_f32_16x16x32_bf16(a, bb, acc, 0, 0, 0);
        }
#pragma unroll
        for (int jj = 0; jj < 4; ++jj) { const int t = 16 * I + q4 * 4 + jj, s = 16 * J + r; o_A[t * KA_LD + swz23(s)] = f2bf(s <= t ? acc[jj] : 0.f); }
    }
    {
        const int pr = tid >> 8, e = tid & 255, I = pr ? 2 : 0, J = I + 1;
        o_A[(16 * I + (e >> 4)) * KA_LD + swz23(16 * J + (e & 15))] = 0;
    }
    __syncthreads();
}

DI void scan_b1_phase(const Params& p, int seg, float* lds, int only = 0) {
    const int G = gridDim.x, c = blockIdx.x;
    if (only != 2) {
        GdnPre pre;
        if (c < 2048) gdn_b1_load(p, seg, c, pre);
        for (int it = c; it < 2048; it += G) gdn_b1_item(p, seg, it, lds, pre, it + G < 2048 ? it + G : it);
    }
    if (only != 1) {
        HgPre pre;
        if (c < 2048) hgrn_b1_load(p, seg, c, pre);
        for (int it = c; it < 2048; it += G) hgrn_b1_item(p, seg, it, lds, pre, it + G < 2048 ? it + G : it);
    }
    if (seg == NSEG - 1 && only == 0) {
        for (int it = c; it < 128; it += G) {
            if (it < 64) { GdnPre pre; gdn_b1_load(p, seg, 2048 + it, pre); gdn_b1_item(p, seg, 2048 + it, lds, pre, 2048 + it); }
            else { HgPre pre; hgrn_b1_load(p, seg, 2048 + it - 64, pre); hgrn_b1_item(p, seg, 2048 + it - 64, lds, pre, 2048 + it - 64); }
        }
    }
}

DI bf16x8 pack_step(const f32x16& x, int s) {
    u32x4 r; r[0] = pk2(x[8 * s], x[8 * s + 1]); r[1] = pk2(x[8 * s + 2], x[8 * s + 3]); r[2] = pk2(x[8 * s + 4], x[8 * s + 5]); r[3] = pk2(x[8 * s + 6], x[8 * s + 7]);
    return __builtin_bit_cast(bf16x8, r);
}
#define MFMA32(a, b, c) __builtin_amdgcn_mfma_f32_32x32x16_bf16((a), (b), (c), 0, 0, 0)
DI bf16x8 ldfrag(const bf16_t* ptr) { return __builtin_bit_cast(bf16x8, *(const u32x4*)ptr); }

constexpr int B2_RED = G_STAGE + H_STAGE;
DI void b2_stage(const unsigned char* src, LAS unsigned char* dst, bool gdn, int tg, int wv) {
    const unsigned char* g = src + (size_t)tg * 16;
    LAS unsigned char* d = dst + wv * 1024;
#pragma unroll
    for (int i = 0; i < 11; ++i) __builtin_amdgcn_global_load_lds((const unsigned*)(g + i * 4096), (LAS unsigned*)(d + i * 4096), 16, 0, 0);
    if (gdn) {
#pragma unroll
        for (int i = 11; i < 15; ++i) __builtin_amdgcn_global_load_lds((const unsigned*)(g + i * 4096), (LAS unsigned*)(d + i * 4096), 16, 0, 0);
        if (wv < 2) __builtin_amdgcn_global_load_lds((const unsigned*)(g + 15 * 4096), (LAS unsigned*)(d + 15 * 4096), 16, 0, 0);
    } else if (wv == 0) __builtin_amdgcn_global_load_lds((const unsigned*)(g + 11 * 4096), (LAS unsigned*)(d + 11 * 4096), 16, 0, 0);
}
DI bf16x8 ldsfrag(const LAS unsigned char* ptr) { return *(const LAS bf16x8*)ptr; }

DI void scan_b2_round(const Params& p, int seg, bool smp, int idx, LAS unsigned char* lds, bool dry = false) {
    const int tid = otid(p.wave), lane = tid & 63, wid = tid >> 6, grp = wid >> 2, wv = wid & 3, r = lane & 31, hh = lane >> 5, tg = tid & 255;
    const bool gdn = grp == 0;
    const int b = idx >> 3, h = idx & 7;
    const int nch = smp ? 1 : 8;
    const int dv = 32 * wv + r;
    const bf16_t* proj = (const bf16_t*)(p.ws + WS_PROJ);
    float* st_out; const float* st_in;
    if (!smp) { st_out = p.out + (gdn ? O_GDNP : O_HGP) + (size_t)idx * 16384; st_in = seg > 0 ? st_out : nullptr; }
    else { st_out = p.out + (gdn ? O_GDNS : O_HGS) + (size_t)idx * 16384; st_in = (gdn ? p.state_gdn : p.state_hgrn) + (size_t)idx * 16384; }
    f32x16 S[4];
#pragma unroll
    for (int kt = 0; kt < 4; ++kt)
#pragma unroll
        for (int i = 0; i < 16; ++i) S[kt][i] = st_in ? st_in[(size_t)(32 * kt + crow(i, hh)) * 128 + dv] : 0.f;
    const float* nwp = (gdn ? p.gdn_norm_w : p.hgrn_norm_w) + 32 * wv + 4 * hh;
    const int gcol = (gdn ? C_GA : C_GH) + h * 128 + 32 * wv + 4 * hh;
    bf16_t* obuf = (bf16_t*)(p.ws + (dry ? WS_MERGED : gdn ? WS_OA : WS_OB)) + h * 128 + 32 * wv + 4 * hh;
    const size_t item_bytes = gdn ? GDN_ITEM : HG_ITEM;
    const unsigned char* items = p.ws + (gdn ? WS_SG : WS_SH);
    LAS unsigned char* tiles = lds + (gdn ? 0 : G_STAGE);
    const LAS unsigned char* t_wneg = tiles + G_WNEG;
    const LAS unsigned char* t_qd = tiles + (gdn ? G_QD : H_QD);
    const LAS unsigned char* t_kdT = tiles + (gdn ? G_KDT : H_KDT);
    const LAS unsigned char* t_A = tiles + (gdn ? G_A : H_A);
    LAS float* red = (LAS float*)(lds + B2_RED);
    const int ut_off = gdn ? G_UT : H_UT;
    u32x2 upf[8];
    {
        const int slot0 = smp ? 2048 + idx : idx * 8;
        const unsigned char* ib = items + (size_t)slot0 * item_bytes;
        b2_stage(ib, tiles, gdn, tg, wv);
#pragma unroll
        for (int mt = 0; mt < 2; ++mt)
#pragma unroll
            for (int g = 0; g < 4; ++g) upf[mt * 4 + g] = *(const u32x2*)((const bf16_t*)(ib + ut_off) + dv * 64 + 32 * mt + 8 * g + 4 * hh);
    }
    asm volatile("s_waitcnt vmcnt(0)" ::: "memory");
    __syncthreads();
    for (int c = 0; c < nch; ++c) {
        const int slot = smp ? 2048 + idx : idx * 8 + c;
        const int row0 = smp ? MSEG + b * SLEN : b * TSEG + c * 64;
        const int nvalid = smp ? SLEN : 64;
        u32x2 gpf[8];
#pragma unroll
        for (int mt = 0; mt < 2; ++mt)
#pragma unroll
            for (int g = 0; g < 4; ++g) gpf[mt * 4 + g] = *(const u32x2*)(proj + (size_t)(row0 + 32 * mt + r) * NP + gcol + 8 * g);
        f32x16 vn[2], o[2];
#pragma unroll
        for (int mt = 0; mt < 2; ++mt)
#pragma unroll
            for (int g = 0; g < 4; ++g) {
                const u32x2 w = upf[mt * 4 + g];
                vn[mt][4 * g] = __uint_as_float(w[0] << 16); vn[mt][4 * g + 1] = __uint_as_float(w[0] & 0xffff0000u);
                vn[mt][4 * g + 2] = __uint_as_float(w[1] << 16); vn[mt][4 * g + 3] = __uint_as_float(w[1] & 0xffff0000u);
            }
#pragma unroll
        for (int mt = 0; mt < 2; ++mt)
#pragma unroll
            for (int i = 0; i < 16; ++i) o[mt][i] = 0.f;
#pragma unroll
        for (int ks = 0; ks < 8; ++ks) {
            const bf16x8 sb = pack_step(S[ks >> 1], ks & 1);
            if (gdn) {
                vn[0] = MFMA32(ldsfrag(t_wneg + (r) * 272 + (16 * ks + 8 * hh) * 2), sb, vn[0]);
                vn[1] = MFMA32(ldsfrag(t_wneg + (32 + r) * 272 + (16 * ks + 8 * hh) * 2), sb, vn[1]);
            }
            o[0] = MFMA32(sb, ldsfrag(t_qd + (r) * 272 + (16 * ks + 8 * hh) * 2), o[0]);
            o[1] = MFMA32(sb, ldsfrag(t_qd + (32 + r) * 272 + (16 * ks + 8 * hh) * 2), o[1]);
        }
        bf16x8 vb[4];
        vb[0] = pack_step(vn[0], 0); vb[1] = pack_step(vn[0], 1); vb[2] = pack_step(vn[1], 0); vb[3] = pack_step(vn[1], 1);
#pragma unroll
        for (int mt = 0; mt < 2; ++mt)
#pragma unroll
            for (int kk = 0; kk < 4; ++kk) { if (kk <= 2 * mt + 1) o[mt] = MFMA32(vb[kk], ldsfrag(t_A + (32 * mt + r) * 144 + (16 * kk + 8 * hh) * 2), o[mt]); }
        if (gdn) { const float ld = *(const LAS float*)(tiles + G_DEC);
#pragma unroll
            for (int kt = 0; kt < 4; ++kt) S[kt] = S[kt] * ld;
        } else { const LAS float* rd = (const LAS float*)(tiles + H_DEC) + 4 * hh;
#pragma unroll
            for (int kt = 0; kt < 4; ++kt)
#pragma unroll
                for (int g = 0; g < 4; ++g) { const f32x4 d4 = *(const LAS f32x4*)(rd + 32 * kt + 8 * g);
                    S[kt][4 * g] *= d4[0]; S[kt][4 * g + 1] *= d4[1]; S[kt][4 * g + 2] *= d4[2]; S[kt][4 * g + 3] *= d4[3]; }
        }
#pragma unroll
        for (int kt = 0; kt < 4; ++kt)
#pragma unroll
            for (int kk = 0; kk < 4; ++kk) { S[kt] = MFMA32(ldsfrag(t_kdT + (32 * kt + r) * 144 + (16 * kk + 8 * hh) * 2), vb[kk], S[kt]); }
        LAS float* redp = red + (c & 1) * 512 + grp * 256;
#pragma unroll
        for (int mt = 0; mt < 2; ++mt) {
            float ss = 0.f;
#pragma unroll
            for (int i = 0; i < 16; ++i) ss += o[mt][i] * o[mt][i];
            ss += shx(ss, lane, 32);
            if (hh == 0) redp[wv * 64 + 32 * mt + r] = ss;
        }
        __syncthreads();
        {
            const unsigned char* ib = items + (size_t)(c + 1 < nch ? slot + 1 : slot) * item_bytes;
            b2_stage(ib, tiles, gdn, tg, wv);
#pragma unroll
            for (int mt = 0; mt < 2; ++mt)
#pragma unroll
                for (int g = 0; g < 4; ++g) upf[mt * 4 + g] = *(const u32x2*)((const bf16_t*)(ib + ut_off) + dv * 64 + 32 * mt + 8 * g + 4 * hh);
        }
        f32x4 nw4[4];
#pragma unroll
        for (int g = 0; g < 4; ++g) nw4[g] = *(const f32x4*)(nwp + 8 * g);
        float tots[2];
#pragma unroll
        for (int mt = 0; mt < 2; ++mt) { const int t = 32 * mt + r; tots[mt] = (redp[t] + redp[64 + t]) + (redp[128 + t] + redp[192 + t]); }
#pragma unroll
        for (int mt = 0; mt < 2; ++mt) {
            const int t = 32 * mt + r;
            const float rs = rsqrtf(tots[mt] * (1.f / 128.f) + 1e-6f);
            if (t < nvalid) {
#pragma unroll
                for (int g = 0; g < 4; ++g) {
                    const u32x2 gw = gpf[mt * 4 + g];
                    float gt[4] = {__uint_as_float(gw[0] << 16), __uint_as_float(gw[0] & 0xffff0000u), __uint_as_float(gw[1] << 16), __uint_as_float(gw[1] & 0xffff0000u)};
                    float ov[4];
#pragma unroll
                    for (int e = 0; e < 4; ++e) { const float gf = gdn ? siluf_(gt[e]) : sigmoidf_(gt[e]); ov[e] = o[mt][4 * g + e] * rs * nw4[g][e] * gf; }
                    u32x2 w; w[0] = pk2(ov[0], ov[1]); w[1] = pk2(ov[2], ov[3]);
                    *(u32x2*)(obuf + (size_t)(row0 + t) * 1024 + 8 * g) = w;
                }
            }
        }
        asm volatile("s_waitcnt vmcnt(0)" ::: "memory");
        __syncthreads();
    }
    if (!dry) {
#pragma unroll
    for (int kt = 0; kt < 4; ++kt)
#pragma unroll
        for (int i = 0; i < 16; ++i) st_out[(size_t)(32 * kt + crow(i, hh)) * 128 + dv] = S[kt][i];
    }
}

#define XB_TMO      128
#define XB_XCNT(j)  (256  + 64 * (j))
#define XB_XSUB(j)  (1280 + 64 * (j))
#define XB_XGEN(j)  (2304 + 64 * (j))
#define XB_TOP      3328
#define XB_TOPGEN   3392
#define XCD_BAR_WORDS 3456
#define XB_SPIN_CAP (1u << 22)
DI unsigned xb_ld(unsigned* p) { return __hip_atomic_load(p, __ATOMIC_RELAXED, __HIP_MEMORY_SCOPE_AGENT); }
DI unsigned xb_add(unsigned* p, unsigned v) { return __hip_atomic_fetch_add(p, v, __ATOMIC_RELAXED, __HIP_MEMORY_SCOPE_AGENT); }
DI unsigned xb_xcc_id() { return (unsigned)__builtin_amdgcn_s_getreg((3 << 11) | 20) & 0xFu; }
#define XB_SPIN(cond, bar) do { unsigned _sp = 0; while (cond) { __builtin_amdgcn_s_sleep(1); \
    if ((++_sp & 255u) == 0u) { if (xb_ld(&(bar)[XB_TMO])) break; if (_sp > XB_SPIN_CAP) { atomicAdd(&(bar)[XB_TMO], 1u); break; } } } } while (0)
struct XcdBarrier { unsigned* bar; unsigned x; volatile LAS unsigned* st; };
DI XcdBarrier xcd_barrier_post(unsigned* bar, volatile LAS unsigned* st, bool leader) {
    XcdBarrier b; b.bar = bar; b.x = xb_xcc_id(); b.st = st;
    if (leader) (void)xb_add(&bar[XB_XCNT(b.x)], 1u);
    return b;
}
DI void xcd_barrier_complete(unsigned* bar, unsigned x, unsigned& nloc, unsigned& nx) {
    const unsigned G = gridDim.x * gridDim.y * gridDim.z;
    unsigned sum, cnt, mine, sp = 0u;
    for (;;) {
        sum = 0u; cnt = 0u; mine = 0u;
#pragma unroll
        for (unsigned j = 0; j < 16; ++j) { const unsigned c = xb_ld(&bar[XB_XCNT(j)]); sum += c; cnt += (c > 0u) ? 1u : 0u; mine = (j == x) ? c : mine; }
        if (sum == G) break;
        __builtin_amdgcn_s_sleep(1);
        if ((++sp & 255u) == 0u) { if (xb_ld(&bar[XB_TMO])) break; if (sp > XB_SPIN_CAP) { atomicAdd(&bar[XB_TMO], 1u); break; } }
    }
    nloc = mine > 0u ? mine : 1u; nx = cnt > 0u ? cnt : 1u;
}
DI void xcd_barrier(const XcdBarrier& b, bool leader) {
    asm volatile("s_waitcnt vmcnt(0)" ::: "memory");
    __syncthreads();
    if (leader) {
        unsigned* bar = b.bar;
        __builtin_amdgcn_s_waitcnt(0);
        unsigned nloc = b.st[0], nx = b.st[1];
        if (nloc == 0u) { xcd_barrier_complete(bar, b.x, nloc, nx); b.st[0] = nloc; b.st[1] = nx; }
        const unsigned old = xb_add(&bar[XB_XSUB(b.x)], 1u);
        const unsigned gen = old / nloc;
        if (old + 1u == (gen + 1u) * nloc) {
            __builtin_amdgcn_fence(__ATOMIC_RELEASE, "agent");
            asm volatile("s_waitcnt vmcnt(0)" ::: "memory");
            const unsigned og = xb_add(&bar[XB_TOP], 1u);
            const unsigned tg = og / nx;
            if (og + 1u == (tg + 1u) * nx) xb_add(&bar[XB_TOPGEN], 1u);
            else XB_SPIN(xb_ld(&bar[XB_TOPGEN]) == tg, bar);
            __builtin_amdgcn_fence(__ATOMIC_ACQUIRE, "agent");
            xb_add(&bar[XB_XGEN(b.x)], 1u);
            asm volatile("s_waitcnt vmcnt(0)" ::: "memory");
        } else {
            XB_SPIN(xb_ld(&bar[XB_XGEN(b.x)]) == gen, bar);
            __builtin_amdgcn_fence(__ATOMIC_ACQUIRE, "agent");
            asm volatile("s_waitcnt vmcnt(0)" ::: "memory");
        }
    }
    __syncthreads();
}

constexpr int LDS_MAIN = 153600;
constexpr int LDS_BYTES = LDS_MAIN + 64;
#ifndef PMASK
#define PMASK 0xFFFF
#endif

__global__ void __launch_bounds__(512) fwd_megakernel(Params pin) {
    Params p = pin; p.wave = __builtin_amdgcn_readfirstlane((int)(threadIdx.x >> 6));
    extern __shared__ __attribute__((aligned(16))) unsigned char shm[];
    cg::grid_group grid = cg::this_grid();
    LAS unsigned char* lds = (LAS unsigned char*)shm;
    float* ldsf = (float*)shm;
    unsigned char* ws = p.ws;
    const int G = gridDim.x, c = blockIdx.x;
    const bool leader = otid(p.wave) == 0;
    if (leader) { *(volatile LAS unsigned*)(lds + LDS_MAIN) = 0u; *(volatile LAS unsigned*)(lds + LDS_MAIN + 4) = 0u; }
    __syncthreads();
    const XcdBarrier xb = xcd_barrier_post((unsigned*)(ws + WS_BAR), (volatile LAS unsigned*)(lds + LDS_MAIN), leader);
#define GSYNC() xcd_barrier(xb, otid(p.wave) == 0)

    if (PMASK & 1) phase0(p, ldsf);
#ifdef REP_P0
    __syncthreads(); phase0(p, ldsf);
#endif
    grid.sync();
    for (int seg = 0; seg < NSEG; ++seg) {
        const int M = MSEG + (seg == NSEG - 1 ? 256 : 0);
        if (seg > 0 && (c & 1)) ln_phase(p, seg - 1, 1);
        if (PMASK & 2) {
            pg8::Gemm g{(const bf16_t*)(ws + WS_XB) + (size_t)seg * MSEG * 1024, (const bf16_t*)(ws + WS_WIN), nullptr, nullptr, M, NPJ, 1024};
            pg8::Order S; S.init(M, NPJ, G, c, 0); S.wave = p.wave;
            EpiProj E{(bf16_t*)(ws + WS_PROJ)};
            pg8::gemm_phase<EpiProj>(lds, g, S, E);
        }
        if (seg > 0 && !(c & 1)) ln_phase(p, seg - 1, 1);
        GSYNC();
#ifdef REP_B2COLD
        for (int idx = c; idx < 256; idx += G) scan_b2_round(p, seg, false, idx, lds, true);
        GSYNC();
#endif
        if (PMASK & 4) scan_b1_phase(p, seg, ldsf);
#ifdef REP_B1
        __syncthreads(); scan_b1_phase(p, seg, ldsf);
#endif
#ifdef REP_B1G
        __syncthreads(); scan_b1_phase(p, seg, ldsf, 1);
#endif
#ifdef REP_B1H
        __syncthreads(); scan_b1_phase(p, seg, ldsf, 2);
#endif
        GSYNC();
#ifdef REP_B2
        for (int idx = c; idx < 256; idx += G) scan_b2_round(p, seg, false, idx, lds, true);
#endif
        if (PMASK & 8) for (int idx = c; idx < 256; idx += G) scan_b2_round(p, seg, false, idx, lds);
        if (PMASK & 8) if (seg == NSEG - 1) for (int idx = c; idx < 64; idx += G) scan_b2_round(p, seg, true, idx, lds);
        GSYNC();
        if (PMASK & 16) {
            pg8::Gemm g{(const bf16_t*)(ws + WS_OA), (const bf16_t*)(ws + WS_WBRA), (const bf16_t*)(ws + WS_OB), (const bf16_t*)(ws + WS_WBRB), M, 1024, 1024};
            pg8::Order S; S.init(M, 1024, G, c, 1); S.wave = p.wave;
            EpiMerge E{(const bf16_t*)(ws + WS_PROJ), (bf16_t*)(ws + WS_MERGED)};
            pg8::gemm_phase<EpiMerge>(lds, g, S, E);
#ifdef REP_C
            __syncthreads(); pg8::gemm_phase<EpiMerge>(lds, g, S, E);
#endif
        }
        GSYNC();
        if (PMASK & 32) {
            pg8::Gemm g{(const bf16_t*)(ws + WS_MERGED), (const bf16_t*)(ws + WS_WOUT), nullptr, nullptr, M, 1024, 1024};
            pg8::Order S; S.init(M, 1024, G, c, 0); S.wave = p.wave;
            EpiRes E{(const bf16_t*)(ws + WS_XB) + (size_t)seg * MSEG * 1024, (bf16_t*)(ws + WS_H)};
            pg8::gemm_phase<EpiRes>(lds, g, S, E);
#ifdef REP_D
            __syncthreads(); pg8::gemm_phase<EpiRes>(lds, g, S, E);
#endif
        }
        GSYNC();
        if (PMASK & 64) ln_phase(p, seg, 0);
#ifdef REP_LN
        ln_phase(p, seg, 0);
#endif
#ifdef REP_SYNC
        GSYNC(); GSYNC(); GSYNC(); GSYNC(); GSYNC(); GSYNC(); GSYNC(); GSYNC();
#endif
        GSYNC();
        if (PMASK & 128) {
            pg8::Gemm g{(const bf16_t*)(ws + WS_X1B), (const bf16_t*)(ws + WS_WGU), nullptr, nullptr, M, 5632, 1024};
            pg8::Order S; S.init(M, 5632, G, c, 0); S.wave = p.wave;
            EpiSwiglu E{(bf16_t*)(ws + WS_ACT)};
            pg8::gemm_phase<EpiSwiglu>(lds, g, S, E);
#ifdef REP_F
            __syncthreads(); pg8::gemm_phase<EpiSwiglu>(lds, g, S, E);
#endif
        }
        GSYNC();
        if (PMASK & 256) {
            pg8::Gemm g{(const bf16_t*)(ws + WS_ACT), (const bf16_t*)(ws + WS_WDN), nullptr, nullptr, M, 1024, DFF};
            pg8::Order S; S.init(M, 1024, G, c, 0); S.wave = p.wave;
            EpiRes E{(const bf16_t*)(ws + WS_X1B), (bf16_t*)(ws + WS_H)};
            pg8::gemm_phase<EpiRes>(lds, g, S, E);
#ifdef REP_G
            __syncthreads(); pg8::gemm_phase<EpiRes>(lds, g, S, E);
#endif
        }
        GSYNC();
        if (seg == NSEG - 1) ln_phase(p, seg, 1);
    }
}

extern "C" void kernel_launch(void* const* d_in, const int* in_sizes, int n_in, void* d_out, int out_size, void* d_ws, size_t ws_size, hipStream_t stream) {
    static int grid_blocks = 0;
    if (grid_blocks == 0) {
        if (n_in != 21 || ws_size < WS_END) { fprintf(stderr, "kernel_launch: unexpected n_in %d or workspace %zu < %zu\n", n_in, ws_size, (size_t)WS_END); grid_blocks = -1; return; }
        int dev = 0, cus = 0, per_cu = 0;
        hipGetDevice(&dev);
        hipDeviceGetAttribute(&cus, hipDeviceAttributeMultiprocessorCount, dev);
        if (hipFuncSetAttribute((const void*)fwd_megakernel, hipFuncAttributeMaxDynamicSharedMemorySize, LDS_BYTES) != hipSuccess) { fprintf(stderr, "kernel_launch: hipFuncSetAttribute failed\n"); grid_blocks = -1; return; }
        hipOccupancyMaxActiveBlocksPerMultiprocessor(&per_cu, (const void*)fwd_megakernel, 512, LDS_BYTES);
        if (per_cu < 1) { fprintf(stderr, "kernel_launch: occupancy query says %d blocks per CU\n", per_cu); per_cu = 1; }
        grid_blocks = cus;
        (void)per_cu;
    }
    if (grid_blocks < 0) return;
    Params p{};
    p.x_prompt = (const float*)d_in[0]; p.x_sample = (const float*)d_in[1]; p.cache_conv = (const float*)d_in[2]; p.state_gdn = (const float*)d_in[3]; p.state_hgrn = (const float*)d_in[4];
    p.w_in = (const float*)d_in[5]; p.conv_w = (const float*)d_in[6]; p.a_log = (const float*)d_in[7]; p.dt_bias = (const float*)d_in[8]; p.gdn_norm_w = (const float*)d_in[9];
    p.lb_logits = (const float*)d_in[10]; p.hgrn_norm_w = (const float*)d_in[11]; p.w_br_a = (const float*)d_in[12]; p.w_br_b = (const float*)d_in[13]; p.w_out = (const float*)d_in[14];
    p.ln1_g = (const float*)d_in[15]; p.ln1_b = (const float*)d_in[16]; p.w_gate_up = (const float*)d_in[17]; p.w_down = (const float*)d_in[18]; p.ln2_g = (const float*)d_in[19]; p.ln2_b = (const float*)d_in[20];
    p.out = (float*)d_out; p.ws = (unsigned char*)d_ws;
    if (hipMemsetAsync((unsigned char*)d_ws + WS_BAR, 0, 16384, stream) != hipSuccess) { fprintf(stderr, "kernel_launch: memset of the barrier words failed\n"); return; }
    void* args[] = {&p};
    hipError_t e = hipLaunchCooperativeKernel((const void*)fwd_megakernel, dim3(grid_blocks), dim3(512), args, LDS_BYTES, stream);
    if (e != hipSuccess) fprintf(stderr, "cooperative launch failed: %s (grid %d)\n", hipGetErrorString(e), grid_blocks);
}
```

```cpp
#include <hip/hip_runtime.h>
#include <hip/hip_cooperative_groups.h>
#include <cstdio>
namespace cg = cooperative_groups;

#define LAS __attribute__((address_space(3)))
typedef unsigned short bf16_t;
typedef short bf16x8 __attribute__((ext_vector_type(8)));
typedef float f32x4 __attribute__((ext_vector_type(4)));
typedef float f32x16 __attribute__((ext_vector_type(16)));
typedef float f32x2 __attribute__((ext_vector_type(2)));
typedef unsigned u32x4 __attribute__((ext_vector_type(4)));
typedef unsigned u32x2 __attribute__((ext_vector_type(2)));
typedef __bf16 bf16x2_t __attribute__((ext_vector_type(2)));
#define DI __device__ __forceinline__

constexpr int DM = 1024, NBATCH = 32, SEQ = 2048, NSEG = 4, TSEG = 512, MSEG = NBATCH * TSEG;
constexpr int SBATCH = 8, SLEN = 16, SROWS = SBATCH * SLEN;
constexpr int NPJ = 10240; constexpr int NP = 10304;
constexpr int DFF = 2816;
constexpr int C_QA = 0, C_KA = 1024, C_VA = 2048, C_GA = 3072, C_QH = 4096, C_FH = 5120, C_IH = 6144, C_GH = 7168, C_MGA = 8192, C_MGB = 9216;
constexpr int CONVCH = 3072;
constexpr float ALPHA = 1.189207115002721f;
constexpr int MMAX = MSEG + 256;
constexpr int NSLOT = 2048 + 64;

constexpr size_t WS_WIN = 0;
constexpr size_t WS_WGU = WS_WIN + (size_t)NPJ * 1024 * 2;
constexpr size_t WS_WDN = WS_WGU + (size_t)5632 * 1024 * 2;
constexpr size_t WS_WBRA = WS_WDN + (size_t)1024 * 2816 * 2;
constexpr size_t WS_WBRB = WS_WBRA + (size_t)1024 * 1024 * 2;
constexpr size_t WS_WOUT = WS_WBRB + (size_t)1024 * 1024 * 2;
constexpr size_t WS_CONVC = WS_WOUT + (size_t)1024 * 1024 * 2;
constexpr size_t WS_XB = WS_CONVC + (size_t)2 * NBATCH * 3 * CONVCH * 4;
constexpr size_t WS_PROJ = WS_XB + (size_t)(65536 + 256) * 1024 * 2;
constexpr size_t WS_OA = WS_PROJ + (size_t)MMAX * NP * 2;
constexpr size_t WS_OB = WS_OA + (size_t)MMAX * 1024 * 2;
constexpr size_t WS_MERGED = WS_OB + (size_t)MMAX * 1024 * 2;
constexpr size_t WS_SCAN = WS_MERGED + (size_t)MMAX * 1024 * 2;
constexpr size_t GDN_ITEM = 79872, HG_ITEM = 62464;
constexpr int G_WNEG = 0, G_QD = 17408, G_KDT = 34816, G_A = 53248, G_DEC = 62464, G_STAGE = 63488, G_UT = 63488;
constexpr int H_QD = 0, H_KDT = 17408, H_A = 35840, H_DEC = 45056, H_STAGE = 46080, H_UT = 46080;
constexpr int WQ_LD = 136, KA_LD = 72;
constexpr size_t WS_SG = WS_SCAN;
constexpr size_t WS_SH = WS_SG + (size_t)NSLOT * GDN_ITEM;
constexpr size_t WS_LD = WS_SH + (size_t)NSLOT * HG_ITEM;
constexpr size_t WS_RD = WS_LD + (size_t)NSLOT * 4 + 256;
constexpr size_t WS_SCAN_END = WS_RD + (size_t)NSLOT * 512;
constexpr size_t WS_H = WS_SCAN;
constexpr size_t WS_X1F = WS_H + (size_t)MMAX * 1024 * 4;
constexpr size_t WS_X1B = WS_X1F + (size_t)MMAX * 1024 * 4;
constexpr size_t WS_ACT = WS_X1B + (size_t)MMAX * 1024 * 2;
constexpr size_t WS_ALIAS_END = WS_ACT + (size_t)MMAX * DFF * 2;
static_assert(WS_ALIAS_END <= WS_SCAN_END, "alias overflow");
constexpr size_t WS_AB = WS_SCAN_END;
constexpr size_t WS_BAR = WS_AB + (size_t)(65536 + 256) * 16 * 4;
constexpr size_t WS_END = WS_BAR + 16384;

constexpr size_t O_YP = 0;
constexpr size_t O_YS = O_YP + (size_t)NBATCH * SEQ * DM;
constexpr size_t O_CONVP = O_YS + (size_t)SROWS * DM;
constexpr size_t O_GDNP = O_CONVP + (size_t)NBATCH * 3 * CONVCH;
constexpr size_t O_HGP = O_GDNP + (size_t)NBATCH * 8 * 128 * 128;
constexpr size_t O_CONVS = O_HGP + (size_t)NBATCH * 8 * 128 * 128;
constexpr size_t O_GDNS = O_CONVS + (size_t)SBATCH * 3 * CONVCH;
constexpr size_t O_HGS = O_GDNS + (size_t)SBATCH * 8 * 128 * 128;

struct Params {
    const float* x_prompt; const float* x_sample; const float* cache_conv; const float* state_gdn; const float* state_hgrn;
    const float* w_in; const float* conv_w; const float* a_log; const float* dt_bias; const float* gdn_norm_w; const float* lb_logits;
    const float* hgrn_norm_w; const float* w_br_a; const float* w_br_b; const float* w_out; const float* ln1_g; const float* ln1_b;
    const float* w_gate_up; const float* w_down; const float* ln2_g; const float* ln2_b;
    float* out; unsigned char* ws;
    int wave; int pad_;
};

DI float bf2f(bf16_t v) { return __uint_as_float(((unsigned)v) << 16); }
DI unsigned pk2(float a, float b) { f32x2 v = {a, b}; bf16x2_t r = __builtin_convertvector(v, bf16x2_t); return __builtin_bit_cast(unsigned, r); }
DI bf16_t f2bf(float a) { return (bf16_t)(pk2(a, 0.f) & 0xffffu); }
DI u32x4 pk8(const float* v) { u32x4 r; r[0] = pk2(v[0], v[1]); r[1] = pk2(v[2], v[3]); r[2] = pk2(v[4], v[5]); r[3] = pk2(v[6], v[7]); return r; }
DI void unpk8(u32x4 r, float* v) {
#pragma unroll
    for (int i = 0; i < 4; ++i) { v[2 * i] = __uint_as_float(r[i] << 16); v[2 * i + 1] = __uint_as_float(r[i] & 0xffff0000u); }
}
DI float sigmoidf_(float x) { return __builtin_amdgcn_rcpf(1.f + __expf(-x)); }
DI float siluf_(float x) { return x * __builtin_amdgcn_rcpf(1.f + __expf(-x)); }
DI int swz23(int x) { return (x & ~12) | ((x & 4) << 1) | ((x & 8) >> 1); }
DI float shx(float v, int lane, int m) { return __builtin_bit_cast(float, __builtin_amdgcn_ds_bpermute((lane ^ m) << 2, __builtin_bit_cast(int, v))); }
DI float shup(float v, int lane, int o) { const int src = lane >= o ? lane - o : lane; return __builtin_bit_cast(float, __builtin_amdgcn_ds_bpermute(src << 2, __builtin_bit_cast(int, v))); }
DI int crow(int i, int h) { return (i & 3) + 8 * (i >> 2) + 4 * h; }
DI int otid(int wave) { int l; asm volatile("v_mbcnt_lo_u32_b32 %0, -1, 0\n\tv_mbcnt_hi_u32_b32 %0, -1, %0" : "=v"(l)); return wave * 64 + l; }

namespace pg8 {
constexpr int BM = 256, BK = 64, HALF = 128, HTB = HALF * BK * 2, STAGE_BYTES = 8 * HTB, NXCD = 8, WGM = 8;
DI int lds_byte(int r, int c) { const int st = (r >> 4) * 2 + (c >> 5), rr = r & 15, cc = c & 31, ob = rr * 64 + cc * 2; return st * 1024 + (ob ^ (((ob >> 9) & 1) << 5)); }
DI void stage_rc(int b, int& R, int& C) { const int st = b / 1024, sb = b % 1024, swz = sb ^ (((sb >> 9) & 1) << 5); R = (st >> 1) * 16 + swz / 64; C = (st & 1) * 32 + (swz % 64) / 2; }
DI int perm32(int rho) { const int n = rho >> 4, i = rho & 15; return 8 * (i >> 2) + 4 * n + (i & 3); }
struct Unit { int pm, pn, sub; };
struct Gemm { const bf16_t* A; const bf16_t* Bt; const bf16_t* A2; const bf16_t* Bt2; int M, N, K; };
struct Order {
    int nM, nN, nwg, G, c, dual, wave;
    DI void init(int M, int N, int G_, int c_, int dual_) { nM = M / BM; nN = N / BM; nwg = nM * nN; G = G_; c = c_; dual = dual_; }
    DI bool next(int i, Unit& u) const {
        const int it = dual ? (i >> 1) : i;
        const long L = (long)it * G + c; if (L >= nwg) return false;
        int wgid = (int)L; { const int q = nwg / NXCD, r = nwg % NXCD, xcd = wgid % NXCD, off = wgid / NXCD; wgid = (xcd < r ? xcd * (q + 1) : r * (q + 1) + (xcd - r) * q) + off; }
        const int nig = WGM * nN, gid = wgid / nig, fm = gid * WGM, gsz = (nM - fm) < WGM ? (nM - fm) : WGM;
        u.pm = fm + ((wgid % nig) % gsz); u.pn = (wgid % nig) / gsz; u.sub = dual ? (i & 1) : 0; return true;
    }
};

template <class Epi>
DI void gemm_phase(LAS unsigned char* lds, const Gemm g, const Order& S, const Epi& E) {
    const int tid = otid(S.wave), wid = __builtin_amdgcn_readfirstlane(tid >> 6), lane = tid & 63, wr = wid >> 2, wc = wid & 3, fr = lane & 15, fq = lane >> 4;
    const int K = g.K, nt = K / BK;
    unsigned voffA[2], voffB[2];
#pragma unroll
    for (int i = 0; i < 2; ++i) { int R, C; stage_rc(tid * 16 + i * 8192, R, C); const int Rb = Epi::PERM ? ((R & ~31) + perm32(R & 31)) : R;
        voffA[i] = (unsigned)(R * K + C) * 2u; voffB[i] = (unsigned)(Rb * K + C) * 2u; }
    const size_t kstep = (size_t)(BK * 2);
    const size_t hstep = (size_t)HALF * K * 2;
    const size_t tstep = 2 * hstep;
    const unsigned ldsw = (unsigned)wid * 1024u;
    const int aoff = lds_byte(wr * 64 + fr, fq * 8), boff = lds_byte(wc * 32 + fr, fq * 8);
#define PG8_SA(b, h) (((b) * 2 + (h)) * HTB)
#define PG8_SB(b, h) ((4 + (b) * 2 + (h)) * HTB)
#define PG8_STAGE(bufoff, gbase, voff) do { _Pragma("unroll") for (int _i = 0; _i < 2; ++_i) \
        __builtin_amdgcn_global_load_lds((const unsigned*)((const char*)(gbase) + (voff)[_i]), (LAS unsigned*)(lds + (bufoff) + ldsw + _i * 8192), 16, 0, 0); } while (0)
#define PG8_LDA(dst, b, h) do { _Pragma("unroll") for (int m = 0; m < 4; ++m) _Pragma("unroll") for (int k = 0; k < 2; ++k) dst[m][k] = *(const LAS bf16x8*)(lds + PG8_SA(b, h) + aoff + m * 2048 + k * 1024); } while (0)
#define PG8_LDB(dst, b, h) do { _Pragma("unroll") for (int n = 0; n < 2; ++n) _Pragma("unroll") for (int k = 0; k < 2; ++k) dst[n][k] = *(const LAS bf16x8*)(lds + PG8_SB(b, h) + boff + n * 2048 + k * 1024); } while (0)
#define PG8_MMA(ai, bj, At, Bt) do { __builtin_amdgcn_s_setprio(1); _Pragma("unroll") for (int m = 0; m < 4; ++m) _Pragma("unroll") for (int n = 0; n < 2; ++n) _Pragma("unroll") for (int k = 0; k < 2; ++k) \
        acc[ai][bj][m][n] = __builtin_amdgcn_mfma_f32_16x16x32_bf16(Bt[n][k], At[m][k], acc[ai][bj][m][n], 0, 0, 0); __builtin_amdgcn_s_setprio(0); } while (0)
#define PG8_WAIT_V(n) asm volatile("s_waitcnt vmcnt(" #n ")" ::: "memory")
#define PG8_WAIT_L(n) asm volatile("s_waitcnt lgkmcnt(" #n ")" ::: "memory")
#define PG8_BAR __builtin_amdgcn_s_barrier()
#define PG8_SCHED __builtin_amdgcn_sched_barrier(0)
    Unit cur, nxt; int ui = 0;
    if (!S.next(0, cur)) return;
    f32x4 acc[2][2][4][2];
#pragma unroll
    for (int a = 0; a < 2; ++a)
#pragma unroll
        for (int b = 0; b < 2; ++b)
#pragma unroll
            for (int m = 0; m < 4; ++m)
#pragma unroll
                for (int n = 0; n < 2; ++n) acc[a][b][m][n] = (f32x4){0.f, 0.f, 0.f, 0.f};
    bf16x8 At[4][2], B0[2][2], B1[2][2];
    const char* cA = (const char*)(cur.sub ? g.A2 : g.A) + (size_t)cur.pm * tstep; const char* cB = (const char*)(cur.sub ? g.Bt2 : g.Bt) + (size_t)cur.pn * tstep;
    PG8_STAGE(PG8_SB(0, 0), cB, voffB); PG8_STAGE(PG8_SA(0, 0), cA, voffA); PG8_STAGE(PG8_SB(0, 1), cB + hstep, voffB); PG8_STAGE(PG8_SA(0, 1), cA + hstep, voffA);
    if (wr == 1) PG8_BAR;
    PG8_WAIT_V(4); PG8_BAR;
    PG8_STAGE(PG8_SB(1, 0), cB + kstep, voffB); PG8_STAGE(PG8_SA(1, 0), cA + kstep, voffA); PG8_STAGE(PG8_SB(1, 1), cB + hstep + kstep, voffB);
    PG8_WAIT_V(6); PG8_BAR;
    for (;;) {
        const bool has_next = S.next(ui + 1, nxt);
        const char* nA = has_next ? (const char*)(nxt.sub ? g.A2 : g.A) + (size_t)nxt.pm * tstep : cA; const char* nB = has_next ? (const char*)(nxt.sub ? g.Bt2 : g.Bt) + (size_t)nxt.pn * tstep : cB;
        for (int t = 0; t < nt; t += 2) {
            const bool last = (t == nt - 2);
            const char* a1 = cA + (size_t)(t + 1) * kstep;
            const char* a2 = last ? nA : cA + (size_t)(t + 2) * kstep; const char* b2 = last ? nB : cB + (size_t)(t + 2) * kstep;
            const char* a3 = a2 + kstep; const char* b3 = b2 + kstep;
            PG8_LDB(B0, 0, 0); PG8_SCHED; PG8_LDA(At, 0, 0); PG8_STAGE(PG8_SA(1, 1), a1 + hstep, voffA);
            PG8_WAIT_L(8); PG8_BAR; PG8_WAIT_L(0); PG8_MMA(0, 0, At, B0); PG8_BAR; PG8_SCHED;
            PG8_LDB(B1, 0, 1); PG8_STAGE(PG8_SB(0, 0), b2, voffB);
            PG8_BAR; PG8_WAIT_L(0); PG8_MMA(0, 1, At, B1); PG8_BAR;
            PG8_LDA(At, 0, 1); PG8_STAGE(PG8_SA(0, 0), a2, voffA);
            PG8_BAR; PG8_WAIT_L(0); PG8_MMA(1, 0, At, B0); PG8_BAR; PG8_SCHED;
            PG8_STAGE(PG8_SB(0, 1), b2 + hstep, voffB);
            PG8_WAIT_V(6); PG8_BAR; PG8_MMA(1, 1, At, B1); PG8_BAR;
            PG8_LDB(B0, 1, 0); PG8_SCHED; PG8_LDA(At, 1, 0); PG8_STAGE(PG8_SA(0, 1), a2 + hstep, voffA);
            PG8_WAIT_L(8); PG8_BAR; PG8_WAIT_L(0); PG8_MMA(0, 0, At, B0); PG8_BAR; PG8_SCHED;
            PG8_LDB(B1, 1, 1); PG8_STAGE(PG8_SB(1, 0), b3, voffB);
            PG8_BAR; PG8_WAIT_L(0); PG8_MMA(0, 1, At, B1); PG8_BAR;
            PG8_LDA(At, 1, 1); PG8_STAGE(PG8_SA(1, 0), a3, voffA);
            PG8_BAR; PG8_WAIT_L(0); PG8_MMA(1, 0, At, B0); PG8_BAR; PG8_SCHED;
            PG8_STAGE(PG8_SB(1, 1), b3 + hstep, voffB);
            PG8_WAIT_V(6); PG8_BAR; PG8_MMA(1, 1, At, B1); PG8_BAR;
        }
        E(acc, cur, wr, wc, fr, fq);
        if (!has_next) break;
#pragma unroll
        for (int a = 0; a < 2; ++a)
#pragma unroll
            for (int b = 0; b < 2; ++b)
#pragma unroll
                for (int m = 0; m < 4; ++m)
#pragma unroll
                    for (int n = 0; n < 2; ++n) acc[a][b][m][n] = (f32x4){0.f, 0.f, 0.f, 0.f};
        cur = nxt; cA = nA; cB = nB; ++ui;
    }
    PG8_WAIT_V(0);
    if (wr == 0) PG8_BAR;
    PG8_BAR;
#undef PG8_SA
#undef PG8_SB
#undef PG8_STAGE
#undef PG8_LDA
#undef PG8_LDB
#undef PG8_MMA
#undef PG8_WAIT_V
#undef PG8_WAIT_L
#undef PG8_BAR
#undef PG8_SCHED
}
}
using pg8::Unit;

struct EpiProj {
    static constexpr bool PERM = true;
    bf16_t* O;
    DI void operator()(const f32x4 (&acc)[2][2][4][2], const Unit& u, int wr, int wc, int fr, int fq) const {
#pragma unroll
        for (int ai = 0; ai < 2; ++ai)
#pragma unroll
            for (int m = 0; m < 4; ++m) {
                const int row = u.pm * 256 + ai * 128 + wr * 64 + m * 16 + fr;
                bf16_t* rowp = O + (size_t)row * NP + u.pn * 256 + wc * 32 + 8 * fq;
#pragma unroll
                for (int bj = 0; bj < 2; ++bj) {
                    u32x4 r; r[0] = pk2(acc[ai][bj][m][0][0], acc[ai][bj][m][0][1]); r[1] = pk2(acc[ai][bj][m][0][2], acc[ai][bj][m][0][3]);
                    r[2] = pk2(acc[ai][bj][m][1][0], acc[ai][bj][m][1][1]); r[3] = pk2(acc[ai][bj][m][1][2], acc[ai][bj][m][1][3]);
                    *(u32x4*)(rowp + bj * 128) = r;
                }
            }
    }
};
struct EpiMerge {
    static constexpr bool PERM = true;
    const bf16_t* proj; bf16_t* merged;
    DI void operator()(const f32x4 (&acc)[2][2][4][2], const Unit& u, int wr, int wc, int fr, int fq) const {
        const int gbase = u.sub ? C_MGB : C_MGA;
        const int row0 = u.pm * 256 + wr * 64 + fr, col0 = u.pn * 256 + wc * 32 + 8 * fq;
#pragma unroll
        for (int ai = 0; ai < 2; ++ai) {
            u32x4 gv[4][2], pv[4][2];
#pragma unroll
            for (int m = 0; m < 4; ++m)
#pragma unroll
                for (int bj = 0; bj < 2; ++bj) gv[m][bj] = *(const u32x4*)(proj + (size_t)(row0 + ai * 128 + m * 16) * NP + gbase + col0 + bj * 128);
            if (u.sub) {
#pragma unroll
                for (int m = 0; m < 4; ++m)
#pragma unroll
                    for (int bj = 0; bj < 2; ++bj) pv[m][bj] = *(const u32x4*)(merged + (size_t)(row0 + ai * 128 + m * 16) * 1024 + col0 + bj * 128);
            } else {
#pragma unroll
                for (int m = 0; m < 4; ++m)
#pragma unroll
                    for (int bj = 0; bj < 2; ++bj) pv[m][bj] = (u32x4){0u, 0u, 0u, 0u};
            }
#pragma unroll
            for (int m = 0; m < 4; ++m)
#pragma unroll
                for (int bj = 0; bj < 2; ++bj) {
                    float g8[8], p8[8], v[8]; unpk8(gv[m][bj], g8); unpk8(pv[m][bj], p8);
#pragma unroll
                    for (int e = 0; e < 8; ++e) v[e] = sigmoidf_(g8[e]) * acc[ai][bj][m][e >> 2][e & 3] + p8[e];
                    *(u32x4*)(merged + (size_t)(row0 + ai * 128 + m * 16) * 1024 + col0 + bj * 128) = pk8(v);
                }
        }
    }
};
struct EpiRes {
    static constexpr bool PERM = false;
    const bf16_t* resb; bf16_t* out;
    DI void operator()(const f32x4 (&acc)[2][2][4][2], const Unit& u, int wr, int wc, int fr, int fq) const {
        const int row0 = u.pm * 256 + wr * 64 + fr, col0 = u.pn * 256 + wc * 32 + 4 * fq;
#pragma unroll
        for (int ai = 0; ai < 2; ++ai) {
            u32x2 rb[4][2][2];
#pragma unroll
            for (int m = 0; m < 4; ++m)
#pragma unroll
                for (int bj = 0; bj < 2; ++bj)
#pragma unroll
                    for (int n = 0; n < 2; ++n) rb[m][bj][n] = *(const u32x2*)(resb + (size_t)(row0 + ai * 128 + m * 16) * 1024 + col0 + bj * 128 + 16 * n);
#pragma unroll
            for (int m = 0; m < 4; ++m)
#pragma unroll
                for (int bj = 0; bj < 2; ++bj)
#pragma unroll
                    for (int n = 0; n < 2; ++n) {
                        const u32x2 w0 = rb[m][bj][n];
                        const f32x4 r = {__uint_as_float(w0[0] << 16), __uint_as_float(w0[0] & 0xffff0000u), __uint_as_float(w0[1] << 16), __uint_as_float(w0[1] & 0xffff0000u)};
                        const f32x4 v = r * ALPHA + acc[ai][bj][m][n];
                        u32x2 w; w[0] = pk2(v[0], v[1]); w[1] = pk2(v[2], v[3]);
                        *(u32x2*)(out + (size_t)(row0 + ai * 128 + m * 16) * 1024 + col0 + bj * 128 + 16 * n) = w;
                    }
        }
    }
};
struct EpiSwiglu {
    static constexpr bool PERM = true;
    bf16_t* act;
    DI void operator()(const f32x4 (&acc)[2][2][4][2], const Unit& u, int wr, int wc, int fr, int fq) const {
#pragma unroll
        for (int ai = 0; ai < 2; ++ai)
#pragma unroll
            for (int m = 0; m < 4; ++m) {
                const int row = u.pm * 256 + ai * 128 + wr * 64 + m * 16 + fr;
                float v[8];
#pragma unroll
                for (int e = 0; e < 8; ++e) v[e] = siluf_(acc[ai][0][m][e >> 2][e & 3]) * acc[ai][1][m][e >> 2][e & 3];
                *(u32x4*)(act + (size_t)row * DFF + u.pn * 128 + wc * 32 + 8 * fq) = pk8(v);
            }
    }
};

DI int mapcol(int mode, int n) {
    if (mode == 0) return n;
    if (mode == 1) return n < 4096 ? n : n + 16;
    const int t = n >> 8, w = n & 255; return w < 128 ? t * 128 + w : DFF + t * 128 + (w - 128);
}
DI void transpose_tile(const float* src, bf16_t* dst, int K, int Nsrc, int mode, int k0, int n0, float* tile, int wave) {
    const int tid = otid(wave), tx = tid & 63, ty = tid >> 6;
    const int sc = mapcol(mode, n0 + tx);
#pragma unroll
    for (int kk = 0; kk < 8; ++kk) { const int kl = ty * 8 + kk; tile[kl * 65 + tx] = sc >= 0 ? src[(size_t)(k0 + kl) * Nsrc + sc] : 0.f; }
    __syncthreads();
    const int nl = tid >> 3, ks = tid & 7;
    float v[8];
#pragma unroll
    for (int j = 0; j < 8; ++j) v[j] = tile[(ks * 8 + j) * 65 + nl];
    *(u32x4*)(dst + (size_t)(n0 + nl) * K + k0 + ks * 8) = pk8(v);
    __syncthreads();
}
DI void phase0(const Params& p, float* ldsf) {
    unsigned char* ws = p.ws;
    int base = 0;
#pragma unroll
    for (int j = 0; j < 6; ++j) {
        const float* src = j == 0 ? p.w_in : j == 1 ? p.w_gate_up : j == 2 ? p.w_down : j == 3 ? p.w_br_a : j == 4 ? p.w_br_b : p.w_out;
        bf16_t* dst = (bf16_t*)(ws + (j == 0 ? WS_WIN : j == 1 ? WS_WGU : j == 2 ? WS_WDN : j == 3 ? WS_WBRA : j == 4 ? WS_WBRB : WS_WOUT));
        const int K = j == 2 ? DFF : 1024, Nsrc = j == 0 ? 10256 : j == 1 ? 5632 : 1024, mode = j == 0 ? 1 : j == 1 ? 2 : 0;
        const int nkj = j == 2 ? 44 : 16, nnj = j == 0 ? 160 : j == 1 ? 88 : 16;
        const int ntile = nkj * nnj;
        for (int t = ((int)blockIdx.x + (int)gridDim.x - (base % (int)gridDim.x)) % (int)gridDim.x; t < ntile; t += gridDim.x)
            transpose_tile(src, dst, K, Nsrc, mode, (t % nkj) * 64, (t / nkj) * 64, ldsf, p.wave);
        base += ntile;
    }
    __syncthreads();
    {
        const int tid = otid(p.wave), lane = tid & 63, wid = tid >> 6, r = lane & 15, q4 = lane >> 4;
        bf16_t* wsm = (bf16_t*)ldsf;
        for (int idx = tid; idx < 16384; idx += 512) { const int k = idx >> 4, n = idx & 15; wsm[n * 1032 + k] = f2bf(p.w_in[(size_t)k * 10256 + 4096 + n]); }
        __syncthreads();
        bf16_t* xb = (bf16_t*)(ws + WS_XB); float* ab = (float*)(ws + WS_AB);
        for (int task = (int)blockIdx.x * 8 + wid; task < (65536 + 256) / 16; task += (int)gridDim.x * 8) {
            const int d = task * 16 + r;
            const float* src;
            if (d < 65536) { const int sg = d >> 14, rem = d & 16383, b = rem >> 9, tl = rem & 511; src = p.x_prompt + ((size_t)b * SEQ + sg * TSEG + tl) * 1024; }
            else if (d < 65536 + SROWS) src = p.x_sample + (size_t)(d - 65536) * 1024;
            else src = nullptr;
            f32x4 acc = {0.f, 0.f, 0.f, 0.f};
#pragma unroll 1
            for (int kb = 0; kb < 4; ++kb) {
                f32x4 a[8], bq[8];
#pragma unroll
                for (int i = 0; i < 8; ++i) {
                    const int k0 = 32 * (8 * kb + i) + 8 * q4;
                    a[i] = (f32x4){0.f, 0.f, 0.f, 0.f}; bq[i] = (f32x4){0.f, 0.f, 0.f, 0.f};
                    if (src) { a[i] = *(const f32x4*)(src + k0); bq[i] = *(const f32x4*)(src + k0 + 4); }
                }
#pragma unroll
                for (int i = 0; i < 8; ++i) {
                    const int k0 = 32 * (8 * kb + i) + 8 * q4;
                    u32x4 pk; pk[0] = pk2(a[i][0], a[i][1]); pk[1] = pk2(a[i][2], a[i][3]); pk[2] = pk2(bq[i][0], bq[i][1]); pk[3] = pk2(bq[i][2], bq[i][3]);
                    *(u32x4*)(xb + (size_t)d * 1024 + k0) = pk;
                    const bf16x8 wf = *(const bf16x8*)(wsm + r * 1032 + k0);
                    acc = __builtin_amdgcn_mfma_f32_16x16x32_bf16(__builtin_bit_cast(bf16x8, pk), wf, acc, 0, 0, 0);
                }
            }
#pragma unroll
            for (int jj = 0; jj < 4; ++jj) ab[(size_t)(task * 16 + 4 * q4 + jj) * 16 + r] = acc[jj];
        }
    }
}

DI void ln_phase(const Params& p, int seg, int mode) {
    const int tid_ = otid(p.wave); const int lane = tid_ & 63, wid = tid_ >> 6;
    const int nrows = MSEG + (seg == NSEG - 1 ? SROWS : 0);
    const bf16_t* H = (const bf16_t*)(p.ws + WS_H);
    const float* gam = mode == 0 ? p.ln1_g : p.ln2_g; const float* bet = mode == 0 ? p.ln1_b : p.ln2_b;
    f32x4 g4[4], b4[4];
#pragma unroll
    for (int j = 0; j < 4; ++j) { g4[j] = *(const f32x4*)(gam + lane * 4 + 256 * j); b4[j] = *(const f32x4*)(bet + lane * 4 + 256 * j); }
    for (int row = (int)blockIdx.x * 8 + wid; row < nrows; row += (int)gridDim.x * 8) {
        const bf16_t* src = H + (size_t)row * 1024;
        f32x4 v[4]; float s = 0.f;
#pragma unroll
        for (int j = 0; j < 4; ++j) { const u32x2 rb = *(const u32x2*)(src + lane * 4 + 256 * j);
            v[j] = (f32x4){__uint_as_float(rb[0] << 16), __uint_as_float(rb[0] & 0xffff0000u), __uint_as_float(rb[1] << 16), __uint_as_float(rb[1] & 0xffff0000u)};
            s += (v[j][0] + v[j][1]) + (v[j][2] + v[j][3]); }
#pragma unroll
        for (int o = 1; o < 64; o <<= 1) s += shx(s, lane, o);
        const float mu = s * (1.f / 1024.f);
        float q = 0.f;
#pragma unroll
        for (int j = 0; j < 4; ++j) { v[j] = v[j] - mu; q += (v[j][0] * v[j][0] + v[j][1] * v[j][1]) + (v[j][2] * v[j][2] + v[j][3] * v[j][3]); }
#pragma unroll
        for (int o = 1; o < 64; o <<= 1) q += shx(q, lane, o);
        const float rstd = rsqrtf(q * (1.f / 1024.f) + 1e-5f);
        if (mode == 0) {
            bf16_t* o2 = (bf16_t*)(p.ws + WS_X1B) + (size_t)row * 1024;
#pragma unroll
            for (int j = 0; j < 4; ++j) { const f32x4 y = v[j] * rstd * g4[j] + b4[j];
                u32x2 r; r[0] = pk2(y[0], y[1]); r[1] = pk2(y[2], y[3]); *(u32x2*)(o2 + lane * 4 + 256 * j) = r; }
        } else {
            float* o1 = row < MSEG ? p.out + O_YP + ((size_t)(row >> 9) * SEQ + seg * TSEG + (row & 511)) * 1024 : p.out + O_YS + (size_t)(row - MSEG) * 1024;
#pragma unroll
            for (int j = 0; j < 4; ++j) { const f32x4 y = v[j] * rstd * g4[j] + b4[j]; *(f32x4*)(o1 + lane * 4 + 256 * j) = y; }
        }
    }
}

constexpr int LQ = 0, LK = 8448, LV = 16896, LL = 25344, LMISC = 29696, LW = 29952;

DI bf16x8 ldsf32_frag(const float* p) {
    const f32x4 a = *(const f32x4*)p, b = *(const f32x4*)(p + 4);
    u32x4 r; r[0] = pk2(a[0], a[1]); r[1] = pk2(a[2], a[3]); r[2] = pk2(b[0], b[1]); r[3] = pk2(b[2], b[3]);
    return __builtin_bit_cast(bf16x8, r);
}
DI void pair_of(int pr, int& I, int& J) { I = 0; int rem = pr; while (rem > I) { rem -= I + 1; ++I; } J = rem; }

struct GdnPre { u32x4 raw[11]; f32x4 wt[4][2]; float aa, ba; };
DI void gdn_b1_load(const Params& p, int seg, int slot, GdnPre& pre) {
    const int tid = otid(p.wave);
    const bool smp = slot >= 2048;
    int b, h, c, row0, nvalid;
    if (!smp) { const int bh = slot >> 3; c = slot & 7; b = bh >> 3; h = bh & 7; row0 = b * TSEG + c * 64; nvalid = 64; }
    else { const int s2 = slot - 2048; b = s2 >> 3; h = s2 & 7; c = 0; row0 = MSEG + b * SLEN; nvalid = SLEN; }
    const bf16_t* proj = (const bf16_t*)(p.ws + WS_PROJ);
    if (tid < 384) {
        const int ch8 = tid & 15, run = (tid >> 4) & 7, tensor = tid >> 7;
        const int col = tensor * 1024 + h * 128 + ch8 * 8, i0 = run * 8;
        const bf16_t* convc_prev = (const bf16_t*)(p.ws + WS_CONVC) + (size_t)((seg + 1) & 1) * NBATCH * 3 * CONVCH;
#pragma unroll
        for (int j = 0; j < 11; ++j) {
            const int ii = i0 - 3 + j;
            if (j >= 3 || run > 0 || (!smp && c > 0)) pre.raw[j] = *(const u32x4*)(proj + (size_t)(row0 + ii) * NP + col);
            else if (smp) { const float* sp = p.cache_conv + ((size_t)b * 3 + j) * CONVCH + col; const f32x4 a = *(const f32x4*)sp, bb = *(const f32x4*)(sp + 4);
                u32x4 r; r[0] = pk2(a[0], a[1]); r[1] = pk2(a[2], a[3]); r[2] = pk2(bb[0], bb[1]); r[3] = pk2(bb[2], bb[3]); pre.raw[j] = r; }
            else if (seg > 0) pre.raw[j] = *(const u32x4*)(convc_prev + ((size_t)b * 3 + j) * CONVCH + col);
            else pre.raw[j] = (u32x4){0u, 0u, 0u, 0u};
        }
#pragma unroll
        for (int d = 0; d < 4; ++d) { const float* wv = p.conv_w + (size_t)d * CONVCH + col; pre.wt[d][0] = *(const f32x4*)wv; pre.wt[d][1] = *(const f32x4*)(wv + 4); }
    } else if (tid < 448) {
        const int i = tid - 384;
        pre.aa = 0.f; pre.ba = 0.f;
        if (i < nvalid) { const float* abp = (const float*)(p.ws + WS_AB) + ((size_t)seg * MSEG + row0 + i) * 16; pre.aa = abp[h]; pre.ba = abp[8 + h]; }
    }
}

DI void gdn_b1_item(const Params& p, int seg, int slot, float* lds, GdnPre& pre, int next_slot) {
    const int tid = otid(p.wave), lane = tid & 63, wid = tid >> 6;
    const bool smp = slot >= 2048;
    int b, h, c, row0, nvalid;
    if (!smp) { const int bh = slot >> 3; c = slot & 7; b = bh >> 3; h = bh & 7; row0 = b * TSEG + c * 64; nvalid = 64; }
    else { const int s2 = slot - 2048; b = s2 >> 3; h = s2 & 7; c = 0; row0 = MSEG + b * SLEN; nvalid = SLEN; }
    float* Q = lds + LQ; float* Kk = lds + LK; float* V = lds + LV; float* Lm = lds + LL; float* misc = lds + LMISC; float* W = lds + LW;
    unsigned char* ib = p.ws + WS_SG + (size_t)slot * GDN_ITEM;
    bf16_t* o_wneg = (bf16_t*)(ib + G_WNEG); bf16_t* o_qd = (bf16_t*)(ib + G_QD); bf16_t* o_kdT = (bf16_t*)(ib + G_KDT); bf16_t* o_A = (bf16_t*)(ib + G_A); bf16_t* o_uT = (bf16_t*)(ib + G_UT);
    if (tid < 384) {
        const int ch8 = tid & 15, run = (tid >> 4) & 7, tensor = tid >> 7;
        const int col = tensor * 1024 + h * 128 + ch8 * 8, i0 = run * 8;
        bf16_t* convc_cur = (bf16_t*)(p.ws + WS_CONVC) + (size_t)(seg & 1) * NBATCH * 3 * CONVCH;
        u32x4 (&raw)[11] = pre.raw; f32x4 (&wt)[4][2] = pre.wt;
        float y[8][8];
#pragma unroll
        for (int n = 0; n < 8; ++n)
#pragma unroll
            for (int e = 0; e < 8; ++e) y[n][e] = 0.f;
#pragma unroll
        for (int j = 0; j < 11; ++j) {
            float u[8]; unpk8(raw[j], u);
#pragma unroll
            for (int d = 0; d < 4; ++d) {
                const int n = j - 3 + d;
                if (n >= 0 && n < 8) {
#pragma unroll
                    for (int e = 0; e < 8; ++e) y[n][e] += wt[3 - d][e >> 2][e & 3] * u[e];
                }
            }
        }
        if (run == (nvalid >> 3) - 1 && (smp || c == 7)) {
#pragma unroll
            for (int j = 0; j < 3; ++j) {
                float u[8]; unpk8(raw[8 + j], u);
                const f32x4 a = {u[0], u[1], u[2], u[3]}, bb = {u[4], u[5], u[6], u[7]};
                if (smp) { float* o = p.out + O_CONVS + ((size_t)b * 3 + j) * CONVCH + col; *(f32x4*)o = a; *(f32x4*)(o + 4) = bb; }
                else {
                    *(u32x4*)(convc_cur + ((size_t)b * 3 + j) * CONVCH + col) = raw[8 + j];
                    if (seg == NSEG - 1) { float* o2 = p.out + O_CONVP + ((size_t)b * 3 + j) * CONVCH + col; *(f32x4*)o2 = a; *(f32x4*)(o2 + 4) = bb; }
                }
            }
        }
        float* dstb = (tensor == 0 ? Q : tensor == 1 ? Kk : V) + ch8 * 8;
#pragma unroll
        for (int n = 0; n < 8; ++n) {
            const bool ok = i0 + n < nvalid;
#pragma unroll
            for (int e = 0; e < 8; ++e) y[n][e] = ok ? siluf_(y[n][e]) : 0.f;
            if (tensor < 2) {
                float ss = 0.f;
#pragma unroll
                for (int e = 0; e < 8; ++e) ss += y[n][e] * y[n][e];
                ss += shx(ss, lane, 1); ss += shx(ss, lane, 2); ss += shx(ss, lane, 4); ss += shx(ss, lane, 8);
                float rs = rsqrtf(ss + 1e-6f); if (tensor == 0) rs *= 0.08838834764831845f;
#pragma unroll
                for (int e = 0; e < 8; ++e) y[n][e] *= rs;
            }
            float* dst = dstb + (i0 + n) * 132;
            *(f32x4*)dst = (f32x4){y[n][0], y[n][1], y[n][2], y[n][3]}; *(f32x4*)(dst + 4) = (f32x4){y[n][4], y[n][5], y[n][6], y[n][7]};
        }
    } else if (tid < 448) {
        const int i = tid - 384;
        float g = 0.f, be = 0.f;
        if (i < nvalid) {
            const float xx = pre.aa + p.dt_bias[h];
            const float sp = fmaxf(xx, 0.f) + __logf(1.f + __expf(-fabsf(xx)));
            g = -__expf(p.a_log[h]) * sp; be = sigmoidf_(pre.ba);
        }
        float x = g;
#pragma unroll
        for (int o = 1; o < 64; o <<= 1) { const float yv = shup(x, lane, o); if (lane >= o) x += yv; }
        misc[i] = g; misc[64 + i] = be; misc[128 + i] = x; misc[192 + i] = __expf(x);
    }
    gdn_b1_load(p, seg, next_slot, pre);
    __syncthreads();
    for (int tl = wid; tl < 20; tl += 8) {
        const int which = tl >= 10; int I, J; pair_of(which ? tl - 10 : tl, I, J);
        const int r = lane & 15, q4 = lane >> 4;
        const float* X = which ? Q : Kk;
        f32x4 acc = {0.f, 0.f, 0.f, 0.f};
#pragma unroll
        for (int ks = 0; ks < 4; ++ks) {
            const int k0 = 32 * ks + 8 * q4;
            acc = __builtin_amdgcn_mfma_f32_16x16x32_bf16(ldsf32_frag(X + (16 * I + r) * 132 + k0), ldsf32_frag(Kk + (16 * J + r) * 132 + k0), acc, 0, 0, 0);
        }
        const int s = 16 * J + r;
#pragma unroll
        for (int jj = 0; jj < 4; ++jj) {
            const int t = 16 * I + 4 * q4 + jj;
            const float dec = __expf(fminf(misc[128 + t] - misc[128 + s], 0.f));
            if (!which) Lm[t * 68 + s] = (s < t) ? misc[64 + t] * acc[jj] * dec : 0.f;
            else o_A[t * KA_LD + swz23(s)] = f2bf((s <= t) ? acc[jj] * dec : 0.f);
        }
    }
    {
        const int pr = tid >> 8, e = tid & 255, I = pr ? 2 : 0, J = I + 1;
        o_A[(16 * I + (e >> 4)) * KA_LD + swz23(16 * J + (e & 15))] = 0;
    }
    __syncthreads();
    if (tid < 256) {
        f32x2 x2[32];
        LAS float* colp = (LAS float*)(tid < 128 ? V + tid : Kk + (tid - 128));
        LAS float* outp = (LAS float*)(tid < 128 ? V + tid : W + (tid - 128));
        const LAS float* Lb = (const LAS float*)Lm; const LAS float* mb = (const LAS float*)misc;
        asm volatile("" : "+v"(Lb), "+v"(mb), "+v"(colp), "+v"(outp));
#pragma unroll
        for (int t = 0; t < 64; ++t) { float v = colp[t * 132] * mb[64 + t]; if (tid >= 128) v *= mb[192 + t]; x2[t >> 1][t & 1] = v; }
#pragma unroll
        for (int t = 1; t < 64; ++t) {
            f32x2 a01 = {0.f, 0.f}, a23 = {0.f, 0.f};
#pragma unroll
            for (int s4 = 0; s4 < (t + 3) / 4; ++s4) {
                const f32x4 l = *(const LAS f32x4*)(Lb + t * 68 + 4 * s4);
                a01 = __builtin_elementwise_fma((f32x2){l[0], l[1]}, x2[2 * s4], a01);
                a23 = __builtin_elementwise_fma((f32x2){l[2], l[3]}, x2[2 * s4 + 1], a23);
            }
            const f32x2 a = a01 + a23;
            x2[t >> 1][t & 1] -= a[0] + a[1];
        }
        const float sg = tid < 128 ? 1.f : -1.f;
#pragma unroll
        for (int t = 0; t < 64; ++t) outp[t * 132] = sg * x2[t >> 1][t & 1];
    } else {
        const int tg = tid - 256;
#pragma unroll
        for (int j = 0; j < 4; ++j) {
            const int uu = tg + 256 * j, t = uu >> 4, gh = uu & 15, G = gh >> 1, hh = gh & 1;
            const float sc = misc[192 + t];
            const f32x4 a = *(const f32x4*)(Q + t * 132 + 16 * G + 4 * hh), bb = *(const f32x4*)(Q + t * 132 + 16 * G + 8 + 4 * hh);
            float v[8] = {a[0] * sc, a[1] * sc, a[2] * sc, a[3] * sc, bb[0] * sc, bb[1] * sc, bb[2] * sc, bb[3] * sc};
            *(u32x4*)(o_qd + t * WQ_LD + 16 * G + 8 * hh) = pk8(v);
        }
        const float gl = misc[128 + 63];
#pragma unroll
        for (int j = 0; j < 4; ++j) {
            const int uu = tg + 256 * j, dk = uu & 127, gh = uu >> 7, G = gh >> 1, hh = gh & 1;
            float v[8];
#pragma unroll
            for (int e = 0; e < 8; ++e) { const int t = 16 * G + 8 * (e >> 2) + 4 * hh + (e & 3); v[e] = Kk[t * 132 + dk] * __expf(gl - misc[128 + t]); }
            *(u32x4*)(o_kdT + dk * KA_LD + 16 * G + 8 * hh) = pk8(v);
        }
        if (tg == 0) *(float*)(ib + G_DEC) = __expf(gl);
    }
    __syncthreads();
#pragma unroll
    for (int j = 0; j < 2; ++j) {
        const int uu = tid + 512 * j, t = uu >> 4, gh = uu & 15, G = gh >> 1, hh = gh & 1;
        const f32x4 a = *(const f32x4*)(W + t * 132 + 16 * G + 4 * hh), bb = *(const f32x4*)(W + t * 132 + 16 * G + 8 + 4 * hh);
        float v[8] = {a[0], a[1], a[2], a[3], bb[0], bb[1], bb[2], bb[3]};
        *(u32x4*)(o_wneg + t * WQ_LD + 16 * G + 8 * hh) = pk8(v);
    }
#pragma unroll
    for (int j = 0; j < 2; ++j) {
        const int uu = tid + 512 * j, dv = uu & 127, t8 = uu >> 7;
        float v[8];
#pragma unroll
        for (int e = 0; e < 8; ++e) v[e] = V[(t8 * 8 + e) * 132 + dv];
        *(u32x4*)(o_uT + dv * 64 + t8 * 8) = pk8(v);
    }
    __syncthreads();
}

struct HgPre { u32x4 qraw[2], zraw[2]; f32x4 l0[2][2], l1[2][2]; unsigned short vt[2][8]; };
DI void hgrn_b1_load(const Params& p, int seg, int slot, HgPre& pre) {
    const int tid = otid(p.wave);
    const bool smp = slot >= 2048;
    int b, h, row0, nvalid;
    if (!smp) { const int bh = slot >> 3, c = slot & 7; b = bh >> 3; h = bh & 7; row0 = b * TSEG + c * 64; nvalid = 64; }
    else { const int s2 = slot - 2048; b = s2 >> 3; h = s2 & 7; row0 = MSEG + b * SLEN; nvalid = SLEN; }
    const bf16_t* proj = (const bf16_t*)(p.ws + WS_PROJ);
#pragma unroll
    for (int j = 0; j < 2; ++j) {
        const int uu = tid + 512 * j, dv = uu & 127, t8 = uu >> 7;
#pragma unroll
        for (int e = 0; e < 8; ++e) { const int t = t8 * 8 + e; pre.vt[j][e] = t < nvalid ? proj[(size_t)(row0 + t) * NP + C_IH + h * 128 + dv] : (unsigned short)0; }
    }
#pragma unroll
    for (int j = 0; j < 2; ++j) {
        const int uu = tid + 512 * j, i = uu >> 4, ch8 = uu & 15, ch = h * 128 + ch8 * 8;
        const int ic = i < nvalid ? i : 0;
        pre.qraw[j] = *(const u32x4*)(proj + (size_t)(row0 + ic) * NP + C_QH + ch);
        pre.zraw[j] = *(const u32x4*)(proj + (size_t)(row0 + ic) * NP + C_FH + ch);
        pre.l0[j][0] = *(const f32x4*)(p.lb_logits + ch); pre.l0[j][1] = *(const f32x4*)(p.lb_logits + ch + 4);
        pre.l1[j][0] = *(const f32x4*)(p.lb_logits + 1024 + ch); pre.l1[j][1] = *(const f32x4*)(p.lb_logits + 1024 + ch + 4);
    }
}

DI void hgrn_b1_item(const Params& p, int seg, int slot, float* lds, HgPre& pre, int next_slot) {
    const int tid = otid(p.wave), lane = tid & 63, wid = tid >> 6;
    const bool smp = slot >= 2048;
    int b, h, row0, nvalid;
    if (!smp) { const int bh = slot >> 3, c = slot & 7; b = bh >> 3; h = bh & 7; row0 = b * TSEG + c * 64; nvalid = 64; }
    else { const int s2 = slot - 2048; b = s2 >> 3; h = s2 & 7; row0 = MSEG + b * SLEN; nvalid = SLEN; }
    float* Q = lds + LQ; float* Kk = lds + LK; float* Bl = lds + LV; float* Tot = lds + LL;
    unsigned char* ib = p.ws + WS_SH + (size_t)slot * HG_ITEM;
    bf16_t* o_qd = (bf16_t*)(ib + H_QD); bf16_t* o_kdT = (bf16_t*)(ib + H_KDT); bf16_t* o_A = (bf16_t*)(ib + H_A); bf16_t* o_uT = (bf16_t*)(ib + H_UT);
    {
#pragma unroll
        for (int j = 0; j < 2; ++j) {
            const int uu = tid + 512 * j, i = uu >> 4, ch8 = uu & 15;
            float q[8], k[8], lf[8];
            if (i < nvalid) {
                float qv[8], zv[8];
                unpk8(pre.qraw[j], qv); unpk8(pre.zraw[j], zv);
#pragma unroll
                for (int e = 0; e < 8; ++e) {
                    const float l0 = pre.l0[j][e >> 2][e & 3], l1 = pre.l1[j][e >> 2][e & 3];
                    const float lbv = __builtin_amdgcn_rcpf(1.f + __expf(l1 - l0));
                    const float sg = sigmoidf_(zv[e]);
                    const float f = lbv + (1.f - lbv) * sg;
                    q[e] = siluf_(qv[e]) * 0.08838834764831845f; k[e] = (1.f - lbv) * (1.f - sg); lf[e] = __logf(f);
                }
            } else {
#pragma unroll
                for (int e = 0; e < 8; ++e) { q[e] = 0.f; k[e] = 0.f; lf[e] = 0.f; }
            }
            *(f32x4*)(Q + i * 132 + ch8 * 8) = (f32x4){q[0], q[1], q[2], q[3]}; *(f32x4*)(Q + i * 132 + ch8 * 8 + 4) = (f32x4){q[4], q[5], q[6], q[7]};
            *(f32x4*)(Kk + i * 132 + ch8 * 8) = (f32x4){k[0], k[1], k[2], k[3]}; *(f32x4*)(Kk + i * 132 + ch8 * 8 + 4) = (f32x4){k[4], k[5], k[6], k[7]};
            *(f32x4*)(Bl + i * 132 + ch8 * 8) = (f32x4){lf[0], lf[1], lf[2], lf[3]}; *(f32x4*)(Bl + i * 132 + ch8 * 8 + 4) = (f32x4){lf[4], lf[5], lf[6], lf[7]};
        }
#pragma unroll
        for (int j = 0; j < 2; ++j) { const int uu = tid + 512 * j, dv = uu & 127, t8 = uu >> 7;
            u32x4 w;
#pragma unroll
            for (int e2 = 0; e2 < 4; ++e2) w[e2] = (unsigned)pre.vt[j][2 * e2] | ((unsigned)pre.vt[j][2 * e2 + 1] << 16);
            *(u32x4*)(o_uT + dv * 64 + t8 * 8) = w; }
    }
    hgrn_b1_load(p, seg, next_slot, pre);
    __syncthreads();
    { const int ch = tid & 127, I = tid >> 7; float sacc = 0.f;
#pragma unroll
        for (int j = 0; j < 16; ++j) { sacc += Bl[(16 * I + j) * 132 + ch]; Bl[(16 * I + j) * 132 + ch] = sacc; }
        Tot[I * 128 + ch] = sacc; }
    __syncthreads();
#pragma unroll
    for (int j = 0; j < 2; ++j) {
        const int uu = tid + 512 * j, t = uu >> 4, gh = uu & 15, G = gh >> 1, hh = gh & 1, I = t >> 4;
        const int c0 = 16 * G + 4 * hh, c1 = c0 + 8;
        f32x4 B0 = {0.f, 0.f, 0.f, 0.f}, B1 = {0.f, 0.f, 0.f, 0.f};
        for (int jj = 0; jj < I; ++jj) { B0 += *(const f32x4*)(Tot + jj * 128 + c0); B1 += *(const f32x4*)(Tot + jj * 128 + c1); }
        const f32x4 a = *(const f32x4*)(Q + t * 132 + c0), bb = *(const f32x4*)(Q + t * 132 + c1), ea = *(const f32x4*)(Bl + t * 132 + c0) + B0, eb = *(const f32x4*)(Bl + t * 132 + c1) + B1;
        float v[8] = {a[0] * __expf(ea[0]), a[1] * __expf(ea[1]), a[2] * __expf(ea[2]), a[3] * __expf(ea[3]), bb[0] * __expf(eb[0]), bb[1] * __expf(eb[1]), bb[2] * __expf(eb[2]), bb[3] * __expf(eb[3])};
        *(u32x4*)(o_qd + t * WQ_LD + 16 * G + 8 * hh) = pk8(v);
    }
#pragma unroll
    for (int j = 0; j < 2; ++j) {
        const int uu = tid + 512 * j, dk = uu & 127, gh = uu >> 7, G = gh >> 1, hh = gh & 1;
        float rest = Tot[G * 128 + dk];
        for (int jj = G + 1; jj < 4; ++jj) rest += Tot[jj * 128 + dk];
        float v[8];
#pragma unroll
        for (int e = 0; e < 8; ++e) { const int t = 16 * G + 8 * (e >> 2) + 4 * hh + (e & 3); v[e] = Kk[t * 132 + dk] * __expf(rest - Bl[t * 132 + dk]); }
        *(u32x4*)(o_kdT + dk * KA_LD + 16 * G + 8 * hh) = pk8(v);
    }
    if (tid < 128) ((float*)(ib + H_DEC))[tid] = __expf((Tot[tid] + Tot[128 + tid]) + (Tot[256 + tid] + Tot[384 + tid]));
    for (int pr = wid; pr < 10; pr += 8) {
        int I, J; pair_of(pr, I, J);
        const int r = lane & 15, q4 = lane >> 4;
        f32x4 acc = {0.f, 0.f, 0.f, 0.f};
#pragma unroll
        for (int ks = 0; ks < 4; ++ks) {
            const int k0 = 32 * ks + 8 * q4;
            float av[8], bv[8];
#pragma unroll
            for (int e4 = 0; e4 < 2; ++e4) {
                f32x4 dd = {0.f, 0.f, 0.f, 0.f};
                for (int jj = J; jj < I; ++jj) dd += *(const f32x4*)(Tot + jj * 128 + k0 + 4 * e4);
                const f32x4 qv = *(const f32x4*)(Q + (16 * I + r) * 132 + k0 + 4 * e4), ql = *(const f32x4*)(Bl + (16 * I + r) * 132 + k0 + 4 * e4);
                const f32x4 kv = *(const f32x4*)(Kk + (16 * J + r) * 132 + k0 + 4 * e4), kl = *(const f32x4*)(Bl + (16 * J + r) * 132 + k0 + 4 * e4);
#pragma unroll
                for (int e = 0; e < 4; ++e) { av[4 * e4 + e] = qv[e] * __expf(ql[e] + dd[e]); bv[4 * e4 + e] = kv[e] * __expf(-kl[e]); }
            }
            const bf16x8 a = __builtin_bit_cast(bf16x8, pk8(av)), bb = __builtin_bit_cast(bf16x8, pk8(bv));
            acc = __builtin_amdgcn_mfma_f32_16x16x32_bf16(a, bb, acc, 0, 0, 0);
        }
#pragma unroll
        for (int jj = 0; jj < 4; ++jj) { const int t = 16 * I + q4 * 4 + jj, s = 16 * J + r; o_A[t * KA_LD + swz23(s)] = f2bf(s <= t ? acc[jj] : 0.f); }
    }
    {
        const int pr = tid >> 8, e = tid & 255, I = pr ? 2 : 0, J = I + 1;
        o_A[(16 * I + (e >> 4)) * KA_LD + swz23(16 * J + (e & 15))] = 0;
    }
    __syncthreads();
}

DI void scan_b1_phase(const Params& p, int seg, float* lds, int only = 0) {
    const int G = gridDim.x, c = blockIdx.x;
    if (only != 2) {
        GdnPre pre;
        if (c < 2048) gdn_b1_load(p, seg, c, pre);
        for (int it = c; it < 2048; it += G) gdn_b1_item(p, seg, it, lds, pre, it + G < 2048 ? it + G : it);
    }
    if (only != 1) {
        HgPre pre;
        if (c < 2048) hgrn_b1_load(p, seg, c, pre);
        for (int it = c; it < 2048; it += G) hgrn_b1_item(p, seg, it, lds, pre, it + G < 2048 ? it + G : it);
    }
    if (seg == NSEG - 1 && only == 0) {
        for (int it = c; it < 128; it += G) {
            if (it < 64) { GdnPre pre; gdn_b1_load(p, seg, 2048 + it, pre); gdn_b1_item(p, seg, 2048 + it, lds, pre, 2048 + it); }
            else { HgPre pre; hgrn_b1_load(p, seg, 2048 + it - 64, pre); hgrn_b1_item(p, seg, 2048 + it - 64, lds, pre, 2048 + it - 64); }
        }
    }
}

DI bf16x8 pack_step(const f32x16& x, int s) {
    u32x4 r; r[0] = pk2(x[8 * s], x[8 * s + 1]); r[1] = pk2(x[8 * s + 2], x[8 * s + 3]); r[2] = pk2(x[8 * s + 4], x[8 * s + 5]); r[3] = pk2(x[8 * s + 6], x[8 * s + 7]);
    return __builtin_bit_cast(bf16x8, r);
}
#define MFMA32(a, b, c) __builtin_amdgcn_mfma_f32_32x32x16_bf16((a), (b), (c), 0, 0, 0)
DI bf16x8 ldfrag(const bf16_t* ptr) { return __builtin_bit_cast(bf16x8, *(const u32x4*)ptr); }

constexpr int B2_RED = G_STAGE + H_STAGE;
DI void b2_stage(const unsigned char* src, LAS unsigned char* dst, bool gdn, int tg, int wv) {
    const unsigned char* g = src + (size_t)tg * 16;
    LAS unsigned char* d = dst + wv * 1024;
#pragma unroll
    for (int i = 0; i < 11; ++i) __builtin_amdgcn_global_load_lds((const unsigned*)(g + i * 4096), (LAS unsigned*)(d + i * 4096), 16, 0, 0);
    if (gdn) {
#pragma unroll
        for (int i = 11; i < 15; ++i) __builtin_amdgcn_global_load_lds((const unsigned*)(g + i * 4096), (LAS unsigned*)(d + i * 4096), 16, 0, 0);
        if (wv < 2) __builtin_amdgcn_global_load_lds((const unsigned*)(g + 15 * 4096), (LAS unsigned*)(d + 15 * 4096), 16, 0, 0);
    } else if (wv == 0) __builtin_amdgcn_global_load_lds((const unsigned*)(g + 11 * 4096), (LAS unsigned*)(d + 11 * 4096), 16, 0, 0);
}
DI bf16x8 ldsfrag(const LAS unsigned char* ptr) { return *(const LAS bf16x8*)ptr; }

DI void scan_b2_round(const Params& p, int seg, bool smp, int idx, LAS unsigned char* lds, bool dry = false) {
    const int tid = otid(p.wave), lane = tid & 63, wid = tid >> 6, grp = wid >> 2, wv = wid & 3, r = lane & 31, hh = lane >> 5, tg = tid & 255;
    const bool gdn = grp == 0;
    const int b = idx >> 3, h = idx & 7;
    const int nch = smp ? 1 : 8;
    const int dv = 32 * wv + r;
    const bf16_t* proj = (const bf16_t*)(p.ws + WS_PROJ);
    float* st_out; const float* st_in;
    if (!smp) { st_out = p.out + (gdn ? O_GDNP : O_HGP) + (size_t)idx * 16384; st_in = seg > 0 ? st_out : nullptr; }
    else { st_out = p.out + (gdn ? O_GDNS : O_HGS) + (size_t)idx * 16384; st_in = (gdn ? p.state_gdn : p.state_hgrn) + (size_t)idx * 16384; }
    f32x16 S[4];
#pragma unroll
    for (int kt = 0; kt < 4; ++kt)
#pragma unroll
        for (int i = 0; i < 16; ++i) S[kt][i] = st_in ? st_in[(size_t)(32 * kt + crow(i, hh)) * 128 + dv] : 0.f;
    const float* nwp = (gdn ? p.gdn_norm_w : p.hgrn_norm_w) + 32 * wv + 4 * hh;
    const int gcol = (gdn ? C_GA : C_GH) + h * 128 + 32 * wv + 4 * hh;
    bf16_t* obuf = (bf16_t*)(p.ws + (dry ? WS_MERGED : gdn ? WS_OA : WS_OB)) + h * 128 + 32 * wv + 4 * hh;
    const size_t item_bytes = gdn ? GDN_ITEM : HG_ITEM;
    const unsigned char* items = p.ws + (gdn ? WS_SG : WS_SH);
    LAS unsigned char* tiles = lds + (gdn ? 0 : G_STAGE);
    const LAS unsigned char* t_wneg = tiles + G_WNEG;
    const LAS unsigned char* t_qd = tiles + (gdn ? G_QD : H_QD);
    const LAS unsigned char* t_kdT = tiles + (gdn ? G_KDT : H_KDT);
    const LAS unsigned char* t_A = tiles + (gdn ? G_A : H_A);
    LAS float* red = (LAS float*)(lds + B2_RED);
    const int ut_off = gdn ? G_UT : H_UT;
    u32x2 upf[8];
    {
        const int slot0 = smp ? 2048 + idx : idx * 8;
        const unsigned char* ib = items + (size_t)slot0 * item_bytes;
        b2_stage(ib, tiles, gdn, tg, wv);
#pragma unroll
        for (int mt = 0; mt < 2; ++mt)
#pragma unroll
            for (int g = 0; g < 4; ++g) upf[mt * 4 + g] = *(const u32x2*)((const bf16_t*)(ib + ut_off) + dv * 64 + 32 * mt + 8 * g + 4 * hh);
    }
    asm volatile("s_waitcnt vmcnt(0)" ::: "memory");
    __syncthreads();
    for (int c = 0; c < nch; ++c) {
        const int slot = smp ? 2048 + idx : idx * 8 + c;
        const int row0 = smp ? MSEG + b * SLEN : b * TSEG + c * 64;
        const int nvalid = smp ? SLEN : 64;
        u32x2 gpf[8];
#pragma unroll
        for (int mt = 0; mt < 2; ++mt)
#pragma unroll
            for (int g = 0; g < 4; ++g) gpf[mt * 4 + g] = *(const u32x2*)(proj + (size_t)(row0 + 32 * mt + r) * NP + gcol + 8 * g);
        f32x16 vn[2], o[2];
#pragma unroll
        for (int mt = 0; mt < 2; ++mt)
#pragma unroll
            for (int g = 0; g < 4; ++g) {
                const u32x2 w = upf[mt * 4 + g];
                vn[mt][4 * g] = __uint_as_float(w[0] << 16); vn[mt][4 * g + 1] = __uint_as_float(w[0] & 0xffff0000u);
                vn[mt][4 * g + 2] = __uint_as_float(w[1] << 16); vn[mt][4 * g + 3] = __uint_as_float(w[1] & 0xffff0000u);
            }
#pragma unroll
        for (int mt = 0; mt < 2; ++mt)
#pragma unroll
            for (int i = 0; i < 16; ++i) o[mt][i] = 0.f;
#pragma unroll
        for (int ks = 0; ks < 8; ++ks) {
            const bf16x8 sb = pack_step(S[ks >> 1], ks & 1);
            if (gdn) {
                vn[0] = MFMA32(ldsfrag(t_wneg + (r) * 272 + (16 * ks + 8 * hh) * 2), sb, vn[0]);
                vn[1] = MFMA32(ldsfrag(t_wneg + (32 + r) * 272 + (16 * ks + 8 * hh) * 2), sb, vn[1]);
            }
            o[0] = MFMA32(sb, ldsfrag(t_qd + (r) * 272 + (16 * ks + 8 * hh) * 2), o[0]);
            o[1] = MFMA32(sb, ldsfrag(t_qd + (32 + r) * 272 + (16 * ks + 8 * hh) * 2), o[1]);
        }
        bf16x8 vb[4];
        vb[0] = pack_step(vn[0], 0); vb[1] = pack_step(vn[0], 1); vb[2] = pack_step(vn[1], 0); vb[3] = pack_step(vn[1], 1);
#pragma unroll
        for (int mt = 0; mt < 2; ++mt)
#pragma unroll
            for (int kk = 0; kk < 4; ++kk) { if (kk <= 2 * mt + 1) o[mt] = MFMA32(vb[kk], ldsfrag(t_A + (32 * mt + r) * 144 + (16 * kk + 8 * hh) * 2), o[mt]); }
        if (gdn) { const float ld = *(const LAS float*)(tiles + G_DEC);
#pragma unroll
            for (int kt = 0; kt < 4; ++kt) S[kt] = S[kt] * ld;
        } else { const LAS float* rd = (const LAS float*)(tiles + H_DEC) + 4 * hh;
#pragma unroll
            for (int kt = 0; kt < 4; ++kt)
#pragma unroll
                for (int g = 0; g < 4; ++g) { const f32x4 d4 = *(const LAS f32x4*)(rd + 32 * kt + 8 * g);
                    S[kt][4 * g] *= d4[0]; S[kt][4 * g + 1] *= d4[1]; S[kt][4 * g + 2] *= d4[2]; S[kt][4 * g + 3] *= d4[3]; }
        }
#pragma unroll
        for (int kt = 0; kt < 4; ++kt)
#pragma unroll
            for (int kk = 0; kk < 4; ++kk) { S[kt] = MFMA32(ldsfrag(t_kdT + (32 * kt + r) * 144 + (16 * kk + 8 * hh) * 2), vb[kk], S[kt]); }
        LAS float* redp = red + (c & 1) * 512 + grp * 256;
#pragma unroll
        for (int mt = 0; mt < 2; ++mt) {
            float ss = 0.f;
#pragma unroll
            for (int i = 0; i < 16; ++i) ss += o[mt][i] * o[mt][i];
            ss += shx(ss, lane, 32);
            if (hh == 0) redp[wv * 64 + 32 * mt + r] = ss;
        }
        __syncthreads();
        {
            const unsigned char* ib = items + (size_t)(c + 1 < nch ? slot + 1 : slot) * item_bytes;
            b2_stage(ib, tiles, gdn, tg, wv);
#pragma unroll
            for (int mt = 0; mt < 2; ++mt)
#pragma unroll
                for (int g = 0; g < 4; ++g) upf[mt * 4 + g] = *(const u32x2*)((const bf16_t*)(ib + ut_off) + dv * 64 + 32 * mt + 8 * g + 4 * hh);
        }
        f32x4 nw4[4];
#pragma unroll
        for (int g = 0; g < 4; ++g) nw4[g] = *(const f32x4*)(nwp + 8 * g);
        float tots[2];
#pragma unroll
        for (int mt = 0; mt < 2; ++mt) { const int t = 32 * mt + r; tots[mt] = (redp[t] + redp[64 + t]) + (redp[128 + t] + redp[192 + t]); }
#pragma unroll
        for (int mt = 0; mt < 2; ++mt) {
            const int t = 32 * mt + r;
            const float rs = rsqrtf(tots[mt] * (1.f / 128.f) + 1e-6f);
            if (t < nvalid) {
#pragma unroll
                for (int g = 0; g < 4; ++g) {
                    const u32x2 gw = gpf[mt * 4 + g];
                    float gt[4] = {__uint_as_float(gw[0] << 16), __uint_as_float(gw[0] & 0xffff0000u), __uint_as_float(gw[1] << 16), __uint_as_float(gw[1] & 0xffff0000u)};
                    float ov[4];
#pragma unroll
                    for (int e = 0; e < 4; ++e) { const float gf = gdn ? siluf_(gt[e]) : sigmoidf_(gt[e]); ov[e] = o[mt][4 * g + e] * rs * nw4[g][e] * gf; }
                    u32x2 w; w[0] = pk2(ov[0], ov[1]); w[1] = pk2(ov[2], ov[3]);
                    *(u32x2*)(obuf + (size_t)(row0 + t) * 1024 + 8 * g) = w;
                }
            }
        }
        asm volatile("s_waitcnt vmcnt(0)" ::: "memory");
        __syncthreads();
    }
    if (!dry) {
#pragma unroll
    for (int kt = 0; kt < 4; ++kt)
#pragma unroll
        for (int i = 0; i < 16; ++i) st_out[(size_t)(32 * kt + crow(i, hh)) * 128 + dv] = S[kt][i];
    }
}

#define XB_TMO      128
#define XB_XCNT(j)  (256  + 64 * (j))
#define XB_XSUB(j)  (1280 + 64 * (j))
#define XB_XGEN(j)  (2304 + 64 * (j))
#define XB_TOP      3328
#define XB_TOPGEN   3392
#define XCD_BAR_WORDS 3456
#define XB_SPIN_CAP (1u << 22)
DI unsigned xb_ld(unsigned* p) { return __hip_atomic_load(p, __ATOMIC_RELAXED, __HIP_MEMORY_SCOPE_AGENT); }
DI unsigned xb_add(unsigned* p, unsigned v) { return __hip_atomic_fetch_add(p, v, __ATOMIC_RELAXED, __HIP_MEMORY_SCOPE_AGENT); }
DI unsigned xb_xcc_id() { return (unsigned)__builtin_amdgcn_s_getreg((3 << 11) | 20) & 0xFu; }
#define XB_SPIN(cond, bar) do { unsigned _sp = 0; while (cond) { __builtin_amdgcn_s_sleep(1); \
    if ((++_sp & 255u) == 0u) { if (xb_ld(&(bar)[XB_TMO])) break; if (_sp > XB_SPIN_CAP) { atomicAdd(&(bar)[XB_TMO], 1u); break; } } } } while (0)
struct XcdBarrier { unsigned* bar; unsigned x; volatile LAS unsigned* st; };
DI XcdBarrier xcd_barrier_post(unsigned* bar, volatile LAS unsigned* st, bool leader) {
    XcdBarrier b; b.bar = bar; b.x = xb_xcc_id(); b.st = st;
    if (leader) (void)xb_add(&bar[XB_XCNT(b.x)], 1u);
    return b;
}
DI void xcd_barrier_complete(unsigned* bar, unsigned x, unsigned& nloc, unsigned& nx) {
    const unsigned G = gridDim.x * gridDim.y * gridDim.z;
    unsigned sum, cnt, mine, sp = 0u;
    for (;;) {
        sum = 0u; cnt = 0u; mine = 0u;
#pragma unroll
        for (unsigned j = 0; j < 16; ++j) { const unsigned c = xb_ld(&bar[XB_XCNT(j)]); sum += c; cnt += (c > 0u) ? 1u : 0u; mine = (j == x) ? c : mine; }
        if (sum == G) break;
        __builtin_amdgcn_s_sleep(1);
        if ((++sp & 255u) == 0u) { if (xb_ld(&bar[XB_TMO])) break; if (sp > XB_SPIN_CAP) { atomicAdd(&bar[XB_TMO], 1u); break; } }
    }
    nloc = mine > 0u ? mine : 1u; nx = cnt > 0u ? cnt : 1u;
}
DI void xcd_barrier(const XcdBarrier& b, bool leader) {
    asm volatile("s_waitcnt vmcnt(0)" ::: "memory");
    __syncthreads();
    if (leader) {
        unsigned* bar = b.bar;
        __builtin_amdgcn_s_waitcnt(0);
        unsigned nloc = b.st[0], nx = b.st[1];
        if (nloc == 0u) { xcd_barrier_complete(bar, b.x, nloc, nx); b.st[0] = nloc; b.st[1] = nx; }
        const unsigned old = xb_add(&bar[XB_XSUB(b.x)], 1u);
        const unsigned gen = old / nloc;
        if (old + 1u == (gen + 1u) * nloc) {
            __builtin_amdgcn_fence(__ATOMIC_RELEASE, "agent");
            asm volatile("s_waitcnt vmcnt(0)" ::: "memory");
            const unsigned og = xb_add(&bar[XB_TOP], 1u);
            const unsigned tg = og / nx;
            if (og + 1u == (tg + 1u) * nx) xb_add(&bar[XB_TOPGEN], 1u);
            else XB_SPIN(xb_ld(&bar[XB_TOPGEN]) == tg, bar);
            __builtin_amdgcn_fence(__ATOMIC_ACQUIRE, "agent");
            xb_add(&bar[XB_XGEN(b.x)], 1u);
            asm volatile("s_waitcnt vmcnt(0)" ::: "memory");
        } else {
            XB_SPIN(xb_ld(&bar[XB_XGEN(b.x)]) == gen, bar);
            __builtin_amdgcn_fence(__ATOMIC_ACQUIRE, "agent");
            asm volatile("s_waitcnt vmcnt(0)" ::: "memory");
        }
    }
    __syncthreads();
}

constexpr int LDS_MAIN = 153600;
constexpr int LDS_BYTES = LDS_MAIN + 64;
#ifndef PMASK
#define PMASK 0xFFFF
#endif

__global__ void __launch_bounds__(512) fwd_megakernel(Params pin) {
    Params p = pin; p.wave = __builtin_amdgcn_readfirstlane((int)(threadIdx.x >> 6));
    extern __shared__ __attribute__((aligned(16))) unsigned char shm[];
    cg::grid_group grid = cg::this_grid();
    LAS unsigned char* lds = (LAS unsigned char*)shm;
    float* ldsf = (float*)shm;
    unsigned char* ws = p.ws;
    const int G = gridDim.x, c = blockIdx.x;
    if (c == 0) { unsigned* bw = (unsigned*)(ws + WS_BAR); for (int i = otid(p.wave); i < XCD_BAR_WORDS; i += 512) bw[i] = 0u; }
    if (PMASK & 1) phase0(p, ldsf);
    grid.sync();
    const bool leader = otid(p.wave) == 0;
    if (leader) { *(volatile LAS unsigned*)(lds + LDS_MAIN) = 0u; *(volatile LAS unsigned*)(lds + LDS_MAIN + 4) = 0u; }
    __syncthreads();
    const XcdBarrier xb = xcd_barrier_post((unsigned*)(ws + WS_BAR), (volatile LAS unsigned*)(lds + LDS_MAIN), leader);
#define GSYNC() xcd_barrier(xb, otid(p.wave) == 0)

    for (int seg = 0; seg < NSEG; ++seg) {
        const int M = MSEG + (seg == NSEG - 1 ? 256 : 0);
        if (PMASK & 2) {
            pg8::Gemm g{(const bf16_t*)(ws + WS_XB) + (size_t)seg * MSEG * 1024, (const bf16_t*)(ws + WS_WIN), nullptr, nullptr, M, NPJ, 1024};
            pg8::Order S; S.init(M, NPJ, G, c, 0); S.wave = p.wave;
            EpiProj E{(bf16_t*)(ws + WS_PROJ)};
            pg8::gemm_phase<EpiProj>(lds, g, S, E);
#ifdef REP_G1
            __syncthreads(); pg8::gemm_phase<EpiProj>(lds, g, S, E);
#endif
        }
        GSYNC();
#ifdef REP_B2COLD
        for (int idx = c; idx < 256; idx += G) scan_b2_round(p, seg, false, idx, lds, true);
        GSYNC();
#endif
        if (PMASK & 4) scan_b1_phase(p, seg, ldsf);
#ifdef REP_B1
        __syncthreads(); scan_b1_phase(p, seg, ldsf);
#endif
#ifdef REP_B1G
        __syncthreads(); scan_b1_phase(p, seg, ldsf, 1);
#endif
#ifdef REP_B1H
        __syncthreads(); scan_b1_phase(p, seg, ldsf, 2);
#endif
        GSYNC();
#ifdef REP_B2
        for (int idx = c; idx < 256; idx += G) scan_b2_round(p, seg, false, idx, lds, true);
#endif
        if (PMASK & 8) for (int idx = c; idx < 256; idx += G) scan_b2_round(p, seg, false, idx, lds);
        if (PMASK & 8) if (seg == NSEG - 1) for (int idx = c; idx < 64; idx += G) scan_b2_round(p, seg, true, idx, lds);
        GSYNC();
        if (PMASK & 16) {
            pg8::Gemm g{(const bf16_t*)(ws + WS_OA), (const bf16_t*)(ws + WS_WBRA), (const bf16_t*)(ws + WS_OB), (const bf16_t*)(ws + WS_WBRB), M, 1024, 1024};
            pg8::Order S; S.init(M, 1024, G, c, 1); S.wave = p.wave;
            EpiMerge E{(const bf16_t*)(ws + WS_PROJ), (bf16_t*)(ws + WS_MERGED)};
            pg8::gemm_phase<EpiMerge>(lds, g, S, E);
#ifdef REP_C
            __syncthreads(); pg8::gemm_phase<EpiMerge>(lds, g, S, E);
#endif
        }
        GSYNC();
        if (PMASK & 32) {
            pg8::Gemm g{(const bf16_t*)(ws + WS_MERGED), (const bf16_t*)(ws + WS_WOUT), nullptr, nullptr, M, 1024, 1024};
            pg8::Order S; S.init(M, 1024, G, c, 0); S.wave = p.wave;
            EpiRes E{(const bf16_t*)(ws + WS_XB) + (size_t)seg * MSEG * 1024, (bf16_t*)(ws + WS_H)};
            pg8::gemm_phase<EpiRes>(lds, g, S, E);
#ifdef REP_D
            __syncthreads(); pg8::gemm_phase<EpiRes>(lds, g, S, E);
#endif
        }
        GSYNC();
        if (PMASK & 64) ln_phase(p, seg, 0);
#ifdef REP_LN
        ln_phase(p, seg, 0);
#endif
#ifdef REP_SYNC
        GSYNC(); GSYNC(); GSYNC(); GSYNC(); GSYNC(); GSYNC(); GSYNC(); GSYNC();
#endif
        GSYNC();
        if (PMASK & 128) {
            pg8::Gemm g{(const bf16_t*)(ws + WS_X1B), (const bf16_t*)(ws + WS_WGU), nullptr, nullptr, M, 5632, 1024};
            pg8::Order S; S.init(M, 5632, G, c, 0); S.wave = p.wave;
            EpiSwiglu E{(bf16_t*)(ws + WS_ACT)};
            pg8::gemm_phase<EpiSwiglu>(lds, g, S, E);
#ifdef REP_F
            __syncthreads(); pg8::gemm_phase<EpiSwiglu>(lds, g, S, E);
#endif
        }
        GSYNC();
        if (PMASK & 256) {
            pg8::Gemm g{(const bf16_t*)(ws + WS_ACT), (const bf16_t*)(ws + WS_WDN), nullptr, nullptr, M, 1024, DFF};
            pg8::Order S; S.init(M, 1024, G, c, 0); S.wave = p.wave;
            EpiRes E{(const bf16_t*)(ws + WS_X1B), (bf16_t*)(ws + WS_H)};
            pg8::gemm_phase<EpiRes>(lds, g, S, E);
#ifdef REP_G
            __syncthreads(); pg8::gemm_phase<EpiRes>(lds, g, S, E);
#endif
        }
        GSYNC();
        if (PMASK & 512) ln_phase(p, seg, 1);
    }
}

extern "C" void kernel_launch(void* const* d_in, const int* in_sizes, int n_in, void* d_out, int out_size, void* d_ws, size_t ws_size, hipStream_t stream) {
    static int grid_blocks = 0;
    if (grid_blocks == 0) {
        if (n_in != 21 || ws_size < WS_END) { fprintf(stderr, "kernel_launch: unexpected n_in %d or workspace %zu < %zu\n", n_in, ws_size, (size_t)WS_END); grid_blocks = -1; return; }
        int dev = 0, cus = 0, per_cu = 0;
        hipGetDevice(&dev);
        hipDeviceGetAttribute(&cus, hipDeviceAttributeMultiprocessorCount, dev);
        if (hipFuncSetAttribute((const void*)fwd_megakernel, hipFuncAttributeMaxDynamicSharedMemorySize, LDS_BYTES) != hipSuccess) { fprintf(stderr, "kernel_launch: hipFuncSetAttribute failed\n"); grid_blocks = -1; return; }
        hipOccupancyMaxActiveBlocksPerMultiprocessor(&per_cu, (const void*)fwd_megakernel, 512, LDS_BYTES);
        if (per_cu < 1) { fprintf(stderr, "kernel_launch: occupancy query says %d blocks per CU\n", per_cu); per_cu = 1; }
        grid_blocks = cus;
        (void)per_cu;
    }
    if (grid_blocks < 0) return;
    Params p{};
    p.x_prompt = (const float*)d_in[0]; p.x_sample = (const float*)d_in[1]; p.cache_conv = (const float*)d_in[2]; p.state_gdn = (const float*)d_in[3]; p.state_hgrn = (const float*)d_in[4];
    p.w_in = (const float*)d_in[5]; p.conv_w = (const float*)d_in[6]; p.a_log = (const float*)d_in[7]; p.dt_bias = (const float*)d_in[8]; p.gdn_norm_w = (const float*)d_in[9];
    p.lb_logits = (const float*)d_in[10]; p.hgrn_norm_w = (const float*)d_in[11]; p.w_br_a = (const float*)d_in[12]; p.w_br_b = (const float*)d_in[13]; p.w_out = (const float*)d_in[14];
    p.ln1_g = (const float*)d_in[15]; p.ln1_b = (const float*)d_in[16]; p.w_gate_up = (const float*)d_in[17]; p.w_down = (const float*)d_in[18]; p.ln2_g = (const float*)d_in[19]; p.ln2_b = (const float*)d_in[20];
    p.out = (float*)d_out; p.ws = (unsigned char*)d_ws;
    void* args[] = {&p};
    hipError_t e = hipLaunchCooperativeKernel((const void*)fwd_megakernel, dim3(grid_blocks), dim3(512), args, LDS_BYTES, stream);
    if (e != hipSuccess) fprintf(stderr, "cooperative launch failed: %s (grid %d)\n", hipGetErrorString(e), grid_blocks);
}
```
